# Optimizing an MI355X kernel written in HIP

```python
import math
import jax, jax.numpy as jnp
from jax import lax
import numpy as np

D_MODEL = 1024
BATCH = 8
SEQ = 4096
DEPTH = 1

CHUNK = 64
Q_BLOCK = 128
EPS = 1e-6
GLA_HEADS = 4
GLA_DK = D_MODEL // 2 // GLA_HEADS
GLA_DV = D_MODEL // GLA_HEADS
GLA_RANK = 16
GLA_TAU = 16.0
DIFF_HEADS = 8
DIFF_DH = 64
DIFF_DV = 2 * DIFF_DH
D_FF = 2816
CONV_W = 3
IN_SIZES = (
    GLA_HEADS * GLA_DK,
    GLA_HEADS * GLA_DK,
    GLA_HEADS * GLA_DV,
    GLA_HEADS * GLA_DV,
    GLA_RANK,
    DIFF_HEADS * 2 * DIFF_DH,
    DIFF_HEADS * 2 * DIFF_DH,
    DIFF_HEADS * DIFF_DV,
    D_MODEL,
    D_MODEL,
)
IN_DIM = sum(IN_SIZES)

kernel_name = "hybrid_gla_diffattn_convffn_block"


def rms_norm(x, g):
    xf = x.astype(jnp.float32)
    y = xf * lax.rsqrt(jnp.mean(xf * xf, axis=-1, keepdims=True) + EPS)
    return (y * g.astype(jnp.float32)).astype(x.dtype)


def gla_mixer(q, k, v, g, a_code, w_alpha_up, b_alpha, norm_g):
    dt = q.dtype
    f32 = jnp.float32
    B, S, _ = q.shape
    nc = S // CHUNK
    log_a = jax.nn.log_sigmoid((a_code @ w_alpha_up + b_alpha).astype(f32)) / GLA_TAU

    def heads(t, d):
        return t.astype(f32).reshape(B, nc, CHUNK, GLA_HEADS, d).transpose(0, 3, 1, 2, 4)

    qh = heads(q, GLA_DK) * (GLA_DK ** -0.5)
    kh = heads(k, GLA_DK)
    vh = heads(v, GLA_DV)
    bcum = jnp.cumsum(heads(log_a, GLA_DK), axis=3)
    b_last = bcum[..., -1:, :]

    q_fwd = qh * jnp.exp(bcum)
    k_fwd = kh * jnp.exp(-bcum)
    q_bwd = qh * jnp.exp(-bcum)
    k_bwd = kh * jnp.exp(bcum)
    s_fwd = jnp.einsum('bhncd,bhnsd->bhncs', q_fwd, k_fwd)
    s_bwd = jnp.einsum('bhncd,bhnsd->bhncs', q_bwd, k_bwd)
    lower = jnp.tril(jnp.ones((CHUNK, CHUNK), dtype=bool))
    scores = jnp.where(lower, s_fwd, s_bwd)
    o_intra = jnp.einsum('bhncs,bhnse->bhnce', scores, vh)

    delta = jnp.einsum('bhncd,bhnce->bhnde', kh * jnp.exp(b_last - bcum), vh)
    decay = jnp.exp(b_last[..., 0, :])

    def step(state, inp):
        dec, dlt = inp
        return dec[..., None] * state + dlt, state

    init = jnp.zeros((B, GLA_HEADS, GLA_DK, GLA_DV), f32)
    _, s_prev = lax.scan(step, init, (jnp.moveaxis(decay, 2, 0), jnp.moveaxis(delta, 2, 0)))
    s_prev = jnp.moveaxis(s_prev, 0, 2)
    o_inter = jnp.einsum('bhncd,bhnde->bhnce', q_fwd, s_prev)

    o = rms_norm(o_intra + o_inter, norm_g)
    o = o.transpose(0, 2, 3, 1, 4).reshape(B, S, GLA_HEADS * GLA_DV).astype(dt)
    return o * jax.nn.silu(g)


def diff_attention(q, k, v, q_norm_g, k_norm_g, lam_q1, lam_k1, lam_q2, lam_k2,
                   subln_g, lambda_init):
    B, S, _ = q.shape
    f32 = jnp.float32
    qh = rms_norm(q.reshape(B, S, DIFF_HEADS, 2, DIFF_DH), q_norm_g)
    kh = rms_norm(k.reshape(B, S, DIFF_HEADS, 2, DIFF_DH), k_norm_g)
    vh = v.reshape(B, S, DIFF_HEADS, DIFF_DV)
    lam = (jnp.exp(jnp.sum(lam_q1 * lam_k1).astype(f32))
           - jnp.exp(jnp.sum(lam_q2 * lam_k2).astype(f32)) + lambda_init)
    slopes = 2.0 ** (-8.0 * (jnp.arange(DIFF_HEADS, dtype=f32) + 1.0) / DIFF_HEADS)
    kpos = jnp.arange(S)
    kchunk = kpos // CHUNK
    nb = S // Q_BLOCK
    qb = jnp.moveaxis(qh.reshape(B, nb, Q_BLOCK, DIFF_HEADS, 2, DIFF_DH), 1, 0)
    scale = DIFF_DH ** -0.5

    def block(args):
        qblk, i = args
        qpos = i * Q_BLOCK + jnp.arange(Q_BLOCK)
        logits = jnp.einsum('bqhjd,bshjd->bhjqs', qblk, kh).astype(f32) * scale
        dist = jnp.abs(qpos[:, None] - kpos[None, :]).astype(f32)
        logits = logits - (slopes[:, None, None] * dist)[None, :, None]
        allowed = kchunk[None, :] <= (qpos // CHUNK)[:, None]
        logits = jnp.where(allowed, logits, -jnp.inf)
        p = jax.nn.softmax(logits, axis=-1)
        attn = p[:, :, 0] - lam * p[:, :, 1]
        return jnp.einsum('bhqs,bshe->bqhe', attn.astype(vh.dtype), vh)

    o = lax.map(block, (qb, jnp.arange(nb)))
    o = jnp.moveaxis(o, 0, 1).reshape(B, S, DIFF_HEADS, DIFF_DV)
    o = rms_norm(o, subln_g) * (1.0 - lambda_init)
    return o.reshape(B, S, DIFF_HEADS * DIFF_DV)


def conv_ffn(h, w_up, conv_w, conv_b, w_down):
    S = h.shape[1]
    u = h @ w_up
    up = jnp.pad(u, ((0, 0), (CONV_W - 1, 0), (0, 0)))
    u = sum(conv_w[j] * up[:, j:j + S] for j in range(CONV_W)) + conv_b
    a, b = jnp.split(u, 2, axis=-1)
    return (jax.nn.silu(a) * b) @ w_down


def setup_inputs(seed: int = 0) -> dict:
    key = jax.random.key(seed)
    ks = jax.random.split(key, 32)
    L, D, F = DEPTH, D_MODEL, D_FF
    nrm = lambda k, shape, fan: jax.random.normal(k, shape, jnp.float32) * (fan ** -0.5)
    gain = lambda k, shape: 1.0 + 0.05 * jax.random.normal(k, shape, jnp.float32)
    return {
        "x": jax.random.normal(ks[0], (BATCH, SEQ, D), jnp.float32),
        "c": jax.random.normal(ks[1], (BATCH, D), jnp.float32),
        "w_ada": nrm(ks[2], (L, D, 6 * D), D),
        "b_ada": 0.02 * jax.random.normal(ks[3], (L, 6 * D), jnp.float32),
        "norm1_g": gain(ks[4], (L, D)),
        "w_in": nrm(ks[5], (L, D, IN_DIM), D),
        "w_alpha_up": nrm(ks[6], (L, GLA_RANK, GLA_HEADS * GLA_DK), GLA_RANK),
        "b_alpha": 0.5 + 0.1 * jax.random.normal(ks[7], (L, GLA_HEADS * GLA_DK), jnp.float32),
        "gla_norm_g": gain(ks[8], (L, GLA_DV)),
        "q_norm_g": gain(ks[9], (L, DIFF_DH)),
        "k_norm_g": gain(ks[10], (L, DIFF_DH)),
        "lam_q1": 0.1 * jax.random.normal(ks[11], (L, DIFF_DH), jnp.float32),
        "lam_k1": 0.1 * jax.random.normal(ks[12], (L, DIFF_DH), jnp.float32),
        "lam_q2": 0.1 * jax.random.normal(ks[13], (L, DIFF_DH), jnp.float32),
        "lam_k2": 0.1 * jax.random.normal(ks[14], (L, DIFF_DH), jnp.float32),
        "diff_norm_g": gain(ks[15], (L, DIFF_DV)),
        "w_gla_o": nrm(ks[16], (L, GLA_HEADS * GLA_DV, D), GLA_HEADS * GLA_DV),
        "w_diff_o": nrm(ks[17], (L, DIFF_HEADS * DIFF_DV, D), DIFF_HEADS * DIFF_DV),
        "w_out": nrm(ks[18], (L, D, D), D),
        "norm2_g": gain(ks[19], (L, D)),
        "w_up": nrm(ks[20], (L, D, 2 * F), D),
        "conv_w": nrm(ks[21], (L, CONV_W, 2 * F), CONV_W),
        "conv_b": 0.02 * jax.random.normal(ks[22], (L, 2 * F), jnp.float32),
        "w_down": nrm(ks[23], (L, F, D), F),
    }


def reference(x, c, w_ada, b_ada, norm1_g, w_in, w_alpha_up, b_alpha, gla_norm_g,
              q_norm_g, k_norm_g, lam_q1, lam_k1, lam_q2, lam_k2, diff_norm_g,
              w_gla_o, w_diff_o, w_out, norm2_g, w_up, conv_w, conv_b, w_down):
    split_idx = [int(v) for v in np.cumsum(IN_SIZES)[:-1]]
    for layer in range(DEPTH):
        lambda_init = 0.8 - 0.6 * math.exp(-0.3 * layer)
        mod = jax.nn.silu(c) @ w_ada[layer] + b_ada[layer]
        sh1, sc1, gt1, sh2, sc2, gt2 = [m[:, None, :] for m in jnp.split(mod, 6, axis=-1)]

        h = rms_norm(x, norm1_g[layer]) * (1.0 + sc1) + sh1
        proj = h @ w_in[layer]
        (g_q, g_k, g_v, g_g, g_a, d_q, d_k, d_v,
         gate_a, gate_b) = jnp.split(proj, split_idx, axis=-1)
        o_a = gla_mixer(g_q, g_k, g_v, g_g, g_a, w_alpha_up[layer], b_alpha[layer],
                        gla_norm_g[layer])
        o_b = diff_attention(d_q, d_k, d_v, q_norm_g[layer], k_norm_g[layer],
                             lam_q1[layer], lam_k1[layer], lam_q2[layer], lam_k2[layer],
                             diff_norm_g[layer], lambda_init)
        merged = (jax.nn.sigmoid(gate_a) * (o_a @ w_gla_o[layer])
                  + jax.nn.sigmoid(gate_b) * (o_b @ w_diff_o[layer]))
        x = x + gt1 * (merged @ w_out[layer])

        h2 = rms_norm(x, norm2_g[layer]) * (1.0 + sc2) + sh2
        x = x + gt2 * conv_ffn(h2, w_up[layer], conv_w[layer], conv_b[layer], w_down[layer])
    return x
```

```cpp
#include <hip/hip_runtime.h>
#include <hip/hip_cooperative_groups.h>
#include <cstdio>
namespace cg = cooperative_groups;

typedef unsigned short bf16_t;
typedef float f32x4 __attribute__((ext_vector_type(4)));
typedef unsigned u32x4 __attribute__((ext_vector_type(4)));
typedef unsigned u32x2 __attribute__((ext_vector_type(2)));

constexpr int T = 32768;
constexpr int DM = 1024;
constexpr int NIN = 8208;
constexpr float EPS = 1e-6f;
constexpr float LOG2E = 1.4426950408889634f;

__device__ __forceinline__ float bf2f(bf16_t v) { return __uint_as_float(((unsigned)v) << 16); }
__device__ __forceinline__ bf16_t f2bf(float f) { unsigned u = __float_as_uint(f); u += 0x7FFFu + ((u >> 16) & 1u); return (bf16_t)(u >> 16); }
__device__ __forceinline__ unsigned pk2(float lo, float hi) { return (unsigned)f2bf(lo) | ((unsigned)f2bf(hi) << 16); }
__device__ __forceinline__ float siluf(float v) { return v / (1.f + __expf(-v)); }
__device__ __forceinline__ float sigmf(float v) { return 1.f / (1.f + __expf(-v)); }
__device__ __forceinline__ float logsigf(float z) { return fminf(z, 0.f) - log1pf(__expf(-fabsf(z))); }

struct P {
    const float *x, *c, *w_ada, *b_ada, *norm1_g, *w_in, *w_alpha_up, *b_alpha, *gla_norm_g, *q_norm_g, *k_norm_g,
        *lam_q1, *lam_k1, *lam_q2, *lam_k2, *diff_norm_g, *w_gla_o, *w_diff_o, *w_out, *norm2_g, *w_up, *conv_w, *conv_b, *w_down;
    float* out;
    bf16_t *wt_in1, *wt_in2, *wt_gv, *wt_dv, *wt_glao, *wt_diffo, *wt_out, *wt_up, *wt_down;
    float* mod;
    bf16_t* h;
    bf16_t *gq, *gk, *gg, *gvT;
    float *acode, *decay;
    bf16_t* delta;
    bf16_t *dq, *dk, *dvT, *merged, *uh, *act;
    bf16_t *sga, *sgb;
};

__host__ __device__ __forceinline__ int tperm(int q) {
    const int bj = q >> 7, wc = (q >> 5) & 3, n = (q >> 4) & 1, fq = (q >> 2) & 3, j = q & 3;
    return 64 * wc + 16 * fq + 8 * bj + 4 * n + j;
}
__host__ __device__ __forceinline__ int src_logical(int kind, int L) {
    switch (kind) {
        case 0:
            if (L < 1024) return L;
            if (L < 2048) return 2048 + (L - 1024);
            if (L < 3072) return 6160 + (L - 2048);
            if (L < 4096) return 7184 + (L - 3072);
            return (L - 4096) < 16 ? 3072 + (L - 4096) : -1;
        case 1:
            return L < 1024 ? 3088 + L : 4112 + (L - 1024);
        case 4: return L;
        case 5: { const int ch = 128 * (L >> 8) + ((L & 255) >> 1); return (L & 1) * 2816 + ch; }
    }
    return -1;
}
__host__ __device__ __forceinline__ int src_physical(int kind, int prow) {
    if (kind == 2) return 1024 + prow;
    if (kind == 3) return 5136 + prow;
    return src_logical(kind, (prow & ~255) + tperm(prow & 255));
}

struct RedNaive { static __device__ __forceinline__ float sum4(float x) { x += __shfl_xor(x, 1); x += __shfl_xor(x, 2); return x; } };
struct RedFast  { static __device__ __forceinline__ float sum4(float x) { x += __shfl_xor(x, 16); x += __shfl_xor(x, 32); return x; } };

__device__ __forceinline__ void st16_bf16(bf16_t* dst, const float (&v)[16]) {
    u32x4 a, b;
    a.x = pk2(v[0], v[1]); a.y = pk2(v[2], v[3]); a.z = pk2(v[4], v[5]); a.w = pk2(v[6], v[7]);
    b.x = pk2(v[8], v[9]); b.y = pk2(v[10], v[11]); b.z = pk2(v[12], v[13]); b.w = pk2(v[14], v[15]);
    *(u32x4*)dst = a; *(u32x4*)(dst + 8) = b;
}
__device__ __forceinline__ void ld16_bf16(const bf16_t* src, float (&v)[16]) {
    const u32x4 a = *(const u32x4*)src, b = *(const u32x4*)(src + 8);
    const unsigned w[8] = {a.x, a.y, a.z, a.w, b.x, b.y, b.z, b.w};
#pragma unroll
    for (int i = 0; i < 8; ++i) { v[2 * i] = __uint_as_float(w[i] << 16); v[2 * i + 1] = __uint_as_float(w[i] & 0xFFFF0000u); }
}

struct EpiP1 {
    P p;
    template <class RED> __device__ __forceinline__ void apply(int row, int c16, float (&v)[16]) const {
        if (c16 < 512) { st16_bf16(p.gq + (size_t)row * 512 + c16, v); }
        else if (c16 < 1024) { st16_bf16(p.gk + (size_t)row * 512 + (c16 - 512), v); }
        else if (c16 < 2048) {
#pragma unroll
            for (int i = 0; i < 16; ++i) v[i] = siluf(v[i]);
            st16_bf16(p.gg + (size_t)row * 1024 + (c16 - 1024), v);
        } else if (c16 < 4096) {
#pragma unroll
            for (int i = 0; i < 16; ++i) v[i] = sigmf(v[i]);
            bf16_t* dst = c16 < 3072 ? p.sga + (size_t)row * 1024 + (c16 - 2048) : p.sgb + (size_t)row * 1024 + (c16 - 3072);
            st16_bf16(dst, v);
        } else if (c16 == 4096) {
            float* dst = p.acode + (size_t)row * 16;
#pragma unroll
            for (int i = 0; i < 4; ++i) *(f32x4*)(dst + 4 * i) = (f32x4){v[4 * i], v[4 * i + 1], v[4 * i + 2], v[4 * i + 3]};
        }
    }
};
struct EpiP2 {
    P p;
    template <class RED> __device__ __forceinline__ void apply(int row, int c16, float (&v)[16]) const {
        float ss = 0.f;
#pragma unroll
        for (int i = 0; i < 16; ++i) ss += v[i] * v[i];
        ss = RED::sum4(ss);
        const bool isq = c16 < 1024;
        const float rstd = rsqrtf(ss * (1.f / 64.f) + EPS) * (isq ? 0.125f * LOG2E : 1.f);
        const float* g = (isq ? p.q_norm_g : p.k_norm_g) + (c16 & 63);
#pragma unroll
        for (int i = 0; i < 16; ++i) v[i] = v[i] * rstd * g[i];
        bf16_t* dst = isq ? p.dq + (size_t)row * 1024 + c16 : p.dk + (size_t)row * 1024 + (c16 - 1024);
        st16_bf16(dst, v);
    }
};
struct EpiM1 {
    P p;
    template <class RED> __device__ __forceinline__ void apply(int row, int c16, float (&v)[16]) const {
        float g[16]; ld16_bf16(p.sga + (size_t)row * 1024 + c16, g);
#pragma unroll
        for (int i = 0; i < 16; ++i) v[i] *= g[i];
        st16_bf16(p.merged + (size_t)row * 1024 + c16, v);
    }
};
struct EpiMG {
    P p;
    template <class RED> __device__ __forceinline__ void apply(int row, int c16, float (&v)[16]) const {
        float g[16], m[16]; ld16_bf16(p.sgb + (size_t)row * 1024 + c16, g); ld16_bf16(p.merged + (size_t)row * 1024 + c16, m);
#pragma unroll
        for (int i = 0; i < 16; ++i) v[i] = m[i] + g[i] * v[i];
        st16_bf16(p.merged + (size_t)row * 1024 + c16, v);
    }
};
struct EpiRes {
    P p; const float* src; float* dst; int goff; int pad;
    template <class RED> __device__ __forceinline__ void apply(int row, int c16, float (&v)[16]) const {
        const float* gt = p.mod + (size_t)(row >> 12) * 6144 + goff + c16;
        const float* s = src + (size_t)row * 1024 + c16; float* d = dst + (size_t)row * 1024 + c16;
#pragma unroll
        for (int i = 0; i < 4; ++i) {
            const f32x4 xv = *(const f32x4*)(s + 4 * i), gv = *(const f32x4*)(gt + 4 * i);
            f32x4 o; o.x = xv.x + gv.x * v[4 * i]; o.y = xv.y + gv.y * v[4 * i + 1]; o.z = xv.z + gv.z * v[4 * i + 2]; o.w = xv.w + gv.w * v[4 * i + 3];
            *(f32x4*)(d + 4 * i) = o;
        }
    }
};
struct EpiUp {
    P p;
    template <class RED> __device__ __forceinline__ void apply(int row, int c16, float (&v)[16]) const { st16_bf16(p.uh + (size_t)row * 2816 + c16, v); }
};
struct EpiVT {
    bf16_t* dst;
    template <class RED> __device__ __forceinline__ void apply(int row, int c16, float (&v)[16]) const { st16_bf16(dst + (size_t)row * T + c16, v); }
};

struct LA_bf16 { const bf16_t* A; int lda; int pad; __device__ __forceinline__ float operator()(int r, int k) const { return bf2f(A[(size_t)r * lda + k]); } };
struct LB_w { const float* W; int ldw; int kind; int coff; int pad; __device__ __forceinline__ float operator()(int k, int c) const { const int s = src_logical(kind, c + coff); return s < 0 ? 0.f : W[(size_t)k * ldw + s]; } };
struct LA_wT { const float* W; int ldw; int base; __device__ __forceinline__ float operator()(int r, int k) const { return W[(size_t)k * ldw + base + r]; } };
struct LB_hT { const bf16_t* H; __device__ __forceinline__ float operator()(int k, int c) const { return bf2f(H[(size_t)c * 1024 + k]); } };

template <class LA, class LB, class EPI>
__global__ __launch_bounds__(256) void naive_gemm(LA la, LB lb, EPI epi, int K) {
    __shared__ float As[16][65], Bs[16][65], Cs[64][65];
    const int t = threadIdx.x, tx = t & 15, ty = t >> 4;
    const int r0 = blockIdx.y * 64, c0 = blockIdx.x * 64;
    float acc[4][4];
#pragma unroll
    for (int i = 0; i < 4; ++i)
#pragma unroll
        for (int j = 0; j < 4; ++j) acc[i][j] = 0.f;
    for (int k0 = 0; k0 < K; k0 += 16) {
        for (int i = t; i < 1024; i += 256) { const int kk = i & 15, rr = i >> 4; As[kk][rr] = la(r0 + rr, k0 + kk); }
        for (int i = t; i < 1024; i += 256) { const int cc = i & 63, kk = i >> 6; Bs[kk][cc] = lb(k0 + kk, c0 + cc); }
        __syncthreads();
#pragma unroll
        for (int kk = 0; kk < 16; ++kk) {
            float a[4], b[4];
#pragma unroll
            for (int i = 0; i < 4; ++i) { a[i] = As[kk][ty * 4 + i]; b[i] = Bs[kk][tx * 4 + i]; }
#pragma unroll
            for (int i = 0; i < 4; ++i)
#pragma unroll
                for (int j = 0; j < 4; ++j) acc[i][j] += a[i] * b[j];
        }
        __syncthreads();
    }
#pragma unroll
    for (int i = 0; i < 4; ++i)
#pragma unroll
        for (int j = 0; j < 4; ++j) Cs[ty * 4 + i][tx * 4 + j] = acc[i][j];
    __syncthreads();
    {
        const int row = t >> 2, qd = t & 3;
        float v[16];
#pragma unroll
        for (int i = 0; i < 16; ++i) v[i] = Cs[row][qd * 16 + i];
        epi.template apply<RedNaive>(r0 + row, c0 + qd * 16, v);
    }
}

__device__ __forceinline__ void phase_mod(const P& p, float* lds) {
    float* sc = lds; float* red = lds + 8192;
    const int t = threadIdx.x;
    bool ready = false;
    for (int item = blockIdx.x; item < 96; item += gridDim.x) {
        if (!ready) { for (int i = t; i < 8192; i += 512) sc[i] = siluf(p.c[i]); ready = true; __syncthreads(); }
        const int col = item * 64 + (t & 63), ks = t >> 6;
        float acc[8];
#pragma unroll
        for (int b = 0; b < 8; ++b) acc[b] = 0.f;
        for (int k = ks * 128; k < ks * 128 + 128; ++k) {
            const float w = p.w_ada[(size_t)k * 6144 + col];
#pragma unroll
            for (int b = 0; b < 8; ++b) acc[b] += sc[b * 1024 + k] * w;
        }
#pragma unroll
        for (int b = 0; b < 8; ++b) red[(ks * 8 + b) * 64 + (t & 63)] = acc[b];
        __syncthreads();
        {
            const int b = t >> 6, cc = t & 63; float s = 0.f;
#pragma unroll
            for (int k2 = 0; k2 < 8; ++k2) s += red[(k2 * 8 + b) * 64 + cc];
            p.mod[b * 6144 + item * 64 + cc] = s + p.b_ada[item * 64 + cc];
        }
        __syncthreads();
    }
}
__device__ __forceinline__ void convert_one(const float* W, int ldw, int K, bf16_t* dst, int nrows, int kind, float* lds, int& rot) {
    const int ntk = K / 64, nt = (nrows / 64) * ntk, G = gridDim.x, t = threadIdx.x;
    for (int tile = (blockIdx.x + G - rot % G) % G; tile < nt; tile += G) {
        const int p0 = (tile / ntk) * 64, k0 = (tile % ntk) * 64;
        {
            const int pp = t & 63, kq = t >> 6; const int s = src_physical(kind, p0 + pp);
#pragma unroll
            for (int i = 0; i < 8; ++i) { const int kk = kq + 8 * i; lds[kk * 65 + pp] = s < 0 ? 0.f : W[(size_t)(k0 + kk) * ldw + s]; }
        }
        __syncthreads();
        {
            const int pp = t >> 3, ks = (t & 7) * 8; u32x4 o;
            o.x = pk2(lds[(ks + 0) * 65 + pp], lds[(ks + 1) * 65 + pp]); o.y = pk2(lds[(ks + 2) * 65 + pp], lds[(ks + 3) * 65 + pp]);
            o.z = pk2(lds[(ks + 4) * 65 + pp], lds[(ks + 5) * 65 + pp]); o.w = pk2(lds[(ks + 6) * 65 + pp], lds[(ks + 7) * 65 + pp]);
            *(u32x4*)(dst + (size_t)(p0 + pp) * K + k0 + ks) = o;
        }
        __syncthreads();
    }
    rot = (rot + nt) % G;
}
__device__ __forceinline__ void phase_convert(const P& p, float* lds) {
    int rot = 0;
    convert_one(p.w_in, NIN, 1024, p.wt_in1, 4352, 0, lds, rot);
    convert_one(p.w_in, NIN, 1024, p.wt_in2, 2048, 1, lds, rot);
    convert_one(p.w_in, NIN, 1024, p.wt_gv, 1024, 2, lds, rot);
    convert_one(p.w_in, NIN, 1024, p.wt_dv, 1024, 3, lds, rot);
    convert_one(p.w_gla_o, 1024, 1024, p.wt_glao, 1024, 4, lds, rot);
    convert_one(p.w_diff_o, 1024, 1024, p.wt_diffo, 1024, 4, lds, rot);
    convert_one(p.w_out, 1024, 1024, p.wt_out, 1024, 4, lds, rot);
    convert_one(p.w_up, 5632, 1024, p.wt_up, 5632, 5, lds, rot);
    convert_one(p.w_down, 1024, 2816, p.wt_down, 1024, 4, lds, rot);
}

__device__ __forceinline__ void phase_norm(const P& p, const float* src, const float* g, int sh_off, int sc_off, bf16_t* dst) {
    const int lane = threadIdx.x & 63, w = threadIdx.x >> 6;
    for (int vb = blockIdx.x; vb < 256; vb += gridDim.x) {
        const int b = vb >> 5;
        const float* md = p.mod + (size_t)b * 6144;
        f32x4 gs[4], sh[4];
#pragma unroll
        for (int i = 0; i < 4; ++i) {
            const int e = i * 256 + lane * 4;
            const f32x4 gg = *(const f32x4*)(g + e), sc = *(const f32x4*)(md + sc_off + e);
            gs[i] = gg * (sc + 1.f); sh[i] = *(const f32x4*)(md + sh_off + e);
        }
        for (int rr = 0; rr < 16; ++rr) {
            const size_t row = (size_t)vb * 128 + w + 8 * rr;
            f32x4 xv[4]; float ss = 0.f;
#pragma unroll
            for (int i = 0; i < 4; ++i) { xv[i] = *(const f32x4*)(src + row * 1024 + i * 256 + lane * 4); ss += xv[i].x * xv[i].x + xv[i].y * xv[i].y + xv[i].z * xv[i].z + xv[i].w * xv[i].w; }
#pragma unroll
            for (int o = 32; o >= 1; o >>= 1) ss += __shfl_xor(ss, o);
            const float rstd = rsqrtf(ss * (1.f / 1024.f) + EPS);
#pragma unroll
            for (int i = 0; i < 4; ++i) {
                const f32x4 y = xv[i] * rstd * gs[i] + sh[i];
                u32x2 o; o.x = pk2(y.x, y.y); o.y = pk2(y.z, y.w);
                *(u32x2*)(dst + row * 1024 + i * 256 + lane * 4) = o;
            }
        }
    }
}

__device__ __forceinline__ void phase_scan(const P& p) {
    for (int task = blockIdx.x * 512 + threadIdx.x; task < 32 * 4096; task += gridDim.x * 512) {
        const int bh = task >> 12, within = task & 4095, e = within >> 4, d8 = (within & 15) * 8;
        float st[8];
#pragma unroll
        for (int i = 0; i < 8; ++i) st[i] = 0.f;
        for (int n = 0; n < 64; ++n) {
            const size_t ci = (size_t)bh * 64 + n;
            bf16_t* ptr = p.delta + (ci * 256 + e) * 128 + d8;
            const u32x4 dv = *(const u32x4*)ptr;
            const f32x4 d0 = *(const f32x4*)(p.decay + ci * 128 + d8), d1 = *(const f32x4*)(p.decay + ci * 128 + d8 + 4);
            const float dec[8] = {d0.x, d0.y, d0.z, d0.w, d1.x, d1.y, d1.z, d1.w};
            const unsigned w[4] = {dv.x, dv.y, dv.z, dv.w};
            u32x4 o; o.x = pk2(st[0], st[1]); o.y = pk2(st[2], st[3]); o.z = pk2(st[4], st[5]); o.w = pk2(st[6], st[7]);
            *(u32x4*)ptr = o;
#pragma unroll
            for (int i = 0; i < 4; ++i) {
                st[2 * i] = dec[2 * i] * st[2 * i] + __uint_as_float(w[i] << 16);
                st[2 * i + 1] = dec[2 * i + 1] * st[2 * i + 1] + __uint_as_float(w[i] & 0xFFFF0000u);
            }
        }
    }
}

__device__ __forceinline__ void phase_conv(const P& p, int half) {
    for (int blk = blockIdx.x; blk < 512; blk += gridDim.x) {
        for (int task = threadIdx.x; task < 1408; task += 512) {
            const int run = task / 352, cgp = task % 352;
            const int t0 = blk * 64 + run * 16;
            const int chl = cgp * 4, ch = half * 1408 + chl;
            float wa[3][4], wb[3][4], ba[4], bb[4];
#pragma unroll
            for (int j = 0; j < 3; ++j)
#pragma unroll
                for (int i = 0; i < 4; ++i) { wa[j][i] = p.conv_w[j * 5632 + ch + i]; wb[j][i] = p.conv_w[j * 5632 + 2816 + ch + i]; }
#pragma unroll
            for (int i = 0; i < 4; ++i) { ba[i] = p.conv_b[ch + i]; bb[i] = p.conv_b[2816 + ch + i]; }
            float a2[4], a1[4], b2[4], b1[4];
#pragma unroll
            for (int i = 0; i < 4; ++i) { a2[i] = a1[i] = b2[i] = b1[i] = 0.f; }
            if ((t0 & 4095) != 0) {
                const u32x4 r2 = *(const u32x4*)(p.uh + (size_t)(t0 - 2) * 2816 + 2 * chl), r1 = *(const u32x4*)(p.uh + (size_t)(t0 - 1) * 2816 + 2 * chl);
                const unsigned w2[4] = {r2.x, r2.y, r2.z, r2.w}, w1[4] = {r1.x, r1.y, r1.z, r1.w};
#pragma unroll
                for (int i = 0; i < 4; ++i) { a2[i] = __uint_as_float(w2[i] << 16); b2[i] = __uint_as_float(w2[i] & 0xFFFF0000u); a1[i] = __uint_as_float(w1[i] << 16); b1[i] = __uint_as_float(w1[i] & 0xFFFF0000u); }
            }
            for (int tt = 0; tt < 16; ++tt) {
                const u32x4 r0 = *(const u32x4*)(p.uh + (size_t)(t0 + tt) * 2816 + 2 * chl);
                const unsigned w0[4] = {r0.x, r0.y, r0.z, r0.w};
                float o[4];
#pragma unroll
                for (int i = 0; i < 4; ++i) {
                    const float a0 = __uint_as_float(w0[i] << 16), b0 = __uint_as_float(w0[i] & 0xFFFF0000u);
                    const float ca = wa[0][i] * a2[i] + wa[1][i] * a1[i] + wa[2][i] * a0 + ba[i];
                    const float cb = wb[0][i] * b2[i] + wb[1][i] * b1[i] + wb[2][i] * b0 + bb[i];
                    o[i] = siluf(ca) * cb;
                    a2[i] = a1[i]; a1[i] = a0; b2[i] = b1[i]; b1[i] = b0;
                }
                u32x2 ov; ov.x = pk2(o[0], o[1]); ov.y = pk2(o[2], o[3]);
                *(u32x2*)(p.act + (size_t)(t0 + tt) * 2816 + ch) = ov;
            }
        }
    }
}

__device__ __forceinline__ void naive_bcum(const P& p, int hh, size_t tok0, float* bc, float* ac, float* wup) {
    const int t = threadIdx.x;
    for (int i = t; i < 1024; i += 256) ac[i] = p.acode[tok0 * 16 + i];
    for (int i = t; i < 2048; i += 256) wup[i] = p.w_alpha_up[(i >> 7) * 512 + hh * 128 + (i & 127)];
    __syncthreads();
    {
        const int d = t & 127, hf = t >> 7; const float ba = p.b_alpha[hh * 128 + d];
        for (int c = hf * 32; c < hf * 32 + 32; ++c) {
            float z = ba;
#pragma unroll
            for (int r = 0; r < 16; ++r) z += ac[c * 16 + r] * wup[r * 128 + d];
            bc[c * 129 + d] = logsigf(z) * (1.f / 16.f);
        }
    }
    __syncthreads();
    if (t < 128) { float run = 0.f; for (int c = 0; c < 64; ++c) { run += bc[c * 129 + t]; bc[c * 129 + t] = run; } }
    __syncthreads();
}
__global__ __launch_bounds__(256) void naive_g1(P p) {
    extern __shared__ float sm[];
    float* kk = sm; float* bc = kk + 64 * 129; float* ac = bc + 64 * 129; float* wup = ac + 1024;
    const int ci = blockIdx.x, bh = ci >> 6, n = ci & 63, b = bh >> 2, hh = bh & 3, t = threadIdx.x;
    const size_t tok0 = (size_t)b * 4096 + n * 64;
    for (int i = t; i < 8192; i += 256) { const int c = i >> 7, d = i & 127; kk[c * 129 + d] = bf2f(p.gk[(tok0 + c) * 512 + hh * 128 + d]); }
    naive_bcum(p, hh, tok0, bc, ac, wup);
    for (int i = t; i < 8192; i += 256) { const int c = i >> 7, d = i & 127; kk[c * 129 + d] *= __expf(bc[63 * 129 + d] - bc[c * 129 + d]); }
    if (t < 128) p.decay[(size_t)ci * 128 + t] = __expf(bc[63 * 129 + t]);
    __syncthreads();
    const int d = t & 127;
    for (int e = t >> 7; e < 256; e += 2) {
        const bf16_t* vr = p.gvT + (size_t)(hh * 256 + e) * T + tok0;
        float s = 0.f;
        for (int c = 0; c < 64; ++c) s += bf2f(vr[c]) * kk[c * 129 + d];
        p.delta[((size_t)ci * 256 + e) * 128 + d] = f2bf(s);
    }
}
__global__ __launch_bounds__(256) void naive_g3(P p) {
    extern __shared__ float sm[];
    float* qq = sm; float* kk = qq + 64 * 129; float* bc = kk + 64 * 129; float* sc = bc + 64 * 129; float* ac = sc + 64 * 65; float* wup = ac + 1024; float* ssum = wup + 2048;
    const int ci = blockIdx.x, bh = ci >> 6, n = ci & 63, b = bh >> 2, hh = bh & 3, t = threadIdx.x;
    const size_t tok0 = (size_t)b * 4096 + n * 64;
    for (int i = t; i < 8192; i += 256) {
        const int c = i >> 7, d = i & 127;
        qq[c * 129 + d] = bf2f(p.gq[(tok0 + c) * 512 + hh * 128 + d]); kk[c * 129 + d] = bf2f(p.gk[(tok0 + c) * 512 + hh * 128 + d]);
    }
    if (t < 64) ssum[t] = 0.f;
    naive_bcum(p, hh, tok0, bc, ac, wup);
    const float scale = 0.08838834764831845f;
    for (int i = t; i < 4096; i += 256) {
        const int c = i >> 6, s = i & 63; float a = 0.f;
        for (int d = 0; d < 128; ++d) a += qq[c * 129 + d] * kk[s * 129 + d] * __expf(-fabsf(bc[c * 129 + d] - bc[s * 129 + d]));
        sc[c * 65 + s] = a * scale;
    }
    __syncthreads();
    for (int i = t; i < 8192; i += 256) { const int c = i >> 7, d = i & 127; qq[c * 129 + d] *= scale * __expf(bc[c * 129 + d]); }
    __syncthreads();
    float* o = kk;
    {
        const int e = t;
        const bf16_t* vr = p.gvT + (size_t)(hh * 256 + e) * T + tok0;
        const bf16_t* sr = p.delta + ((size_t)ci * 256 + e) * 128;
        for (int c = 0; c < 64; ++c) {
            float a = 0.f;
            for (int s = 0; s < 64; ++s) a += sc[c * 65 + s] * bf2f(vr[s]);
            for (int d = 0; d < 128; ++d) a += qq[c * 129 + d] * bf2f(sr[d]);
            o[c * 256 + e] = a; atomicAdd(&ssum[c], a * a);
        }
    }
    __syncthreads();
    for (int i = t; i < 16384; i += 256) {
        const int c = i >> 8, e = i & 255;
        bf16_t* gp = p.gg + (tok0 + c) * 1024 + hh * 256 + e;
        *gp = f2bf(o[i] * rsqrtf(ssum[c] * (1.f / 256.f) + EPS) * p.gla_norm_g[e] * bf2f(*gp));
    }
}

__device__ __forceinline__ float lambda_full(const P& p) {
    float s1 = 0.f, s2 = 0.f;
    for (int i = 0; i < 64; ++i) { s1 += p.lam_q1[i] * p.lam_k1[i]; s2 += p.lam_q2[i] * p.lam_k2[i]; }
    return __expf(s1) - __expf(s2) + 0.2f;
}
__global__ __launch_bounds__(256) void naive_attn(P p) {
    extern __shared__ float sm[];
    float* qs = sm; float* ks = qs + 2 * 64 * 65; float* vs = ks + 2 * 64 * 65;
    const int c = blockIdx.x, bh = blockIdx.y, b = bh >> 3, hh = bh & 7;
    const int t = threadIdx.x, r = t & 63, part = t >> 6, j = part & 1, eh = part >> 1;
    const size_t tok0 = (size_t)b * 4096 + c * 64;
    for (int i = t; i < 8192; i += 256) { const int jj = i >> 12, rr = (i >> 6) & 63, d = i & 63; qs[(jj * 64 + rr) * 65 + d] = bf2f(p.dq[(tok0 + rr) * 1024 + hh * 128 + jj * 64 + d]); }
    const float lam = lambda_full(p);
    const float sl2 = exp2f(-(float)(hh + 1)) * LOG2E;
    float m = -INFINITY, l = 0.f, acc[64];
#pragma unroll
    for (int e = 0; e < 64; ++e) acc[e] = 0.f;
    const int qpos = c * 64 + r;
    for (int kt = 0; kt <= c; ++kt) {
        __syncthreads();
        for (int i = t; i < 8192; i += 256) { const int jj = i >> 12, ss = (i >> 6) & 63, d = i & 63; ks[(jj * 64 + ss) * 65 + d] = bf2f(p.dk[((size_t)b * 4096 + kt * 64 + ss) * 1024 + hh * 128 + jj * 64 + d]); }
        for (int i = t; i < 8192; i += 256) { const int ss = i & 63, e = i >> 6; vs[ss * 128 + e] = bf2f(p.dvT[(size_t)(hh * 128 + e) * T + (size_t)b * 4096 + kt * 64 + ss]); }
        __syncthreads();
        for (int s = 0; s < 64; ++s) {
            float dot = 0.f;
#pragma unroll
            for (int d = 0; d < 64; ++d) dot += qs[(j * 64 + r) * 65 + d] * ks[(j * 64 + s) * 65 + d];
            const int kpos = kt * 64 + s;
            const float lg = dot - sl2 * fabsf((float)(qpos - kpos));
            if (lg > m) {
                const float a = exp2f(m - lg); l *= a;
#pragma unroll
                for (int e = 0; e < 64; ++e) acc[e] *= a;
                m = lg;
            }
            const float pp = exp2f(lg - m); l += pp;
#pragma unroll
            for (int e = 0; e < 64; ++e) acc[e] += pp * vs[s * 128 + eh * 64 + e];
        }
    }
    __syncthreads();
    float* buf = ks; float* ssum = qs;
    const float inv = 1.f / l;
    if (j == 1) {
#pragma unroll
        for (int e = 0; e < 64; ++e) buf[r * 128 + eh * 64 + e] = lam * acc[e] * inv;
    }
    if (t < 64) ssum[t] = 0.f;
    __syncthreads();
    if (j == 0) {
        float ss = 0.f;
#pragma unroll
        for (int e = 0; e < 64; ++e) { acc[e] = acc[e] * inv - buf[r * 128 + eh * 64 + e]; ss += acc[e] * acc[e]; }
        atomicAdd(&ssum[r], ss);
    }
    __syncthreads();
    if (j == 0) {
        const float rstd = rsqrtf(ssum[r] * (1.f / 128.f) + EPS) * 0.8f;
        bf16_t* dst = p.dq + (tok0 + r) * 1024 + hh * 128 + eh * 64;
#pragma unroll
        for (int e = 0; e < 64; ++e) dst[e] = f2bf(acc[e] * rstd * p.diff_norm_g[eh * 64 + e]);
    }
}

template <int PH> __global__ __launch_bounds__(512, 2) void k_phase(P p, int arg) {
    extern __shared__ float shm[];
    if (PH == 0) { phase_mod(p, shm); __syncthreads(); phase_convert(p, shm); }
    if (PH == 1) phase_norm(p, p.x, p.norm1_g, 0, 1024, p.h);
    if (PH == 4) phase_scan(p);
    if (PH == 10) phase_norm(p, p.out, p.norm2_g, 3072, 4096, p.h);
    if (PH == 12) phase_conv(p, arg);
}

extern "C" void kernel_launch(void* const* d_in, const int* in_sizes, int n_in, void* d_out, int out_size, void* d_ws, size_t ws_size, hipStream_t stream) {
    P p{};
    const float** f = (const float**)&p;
    for (int i = 0; i < 24; ++i) f[i] = (const float*)d_in[i];
    p.out = (float*)d_out;
    char* ws = (char*)d_ws; size_t off = 0;
    const size_t MiB = 1u << 20;
    auto take = [&](size_t bytes) { char* r = ws + off; off += (bytes + 255) & ~(size_t)255; return r; };
    p.wt_in1 = (bf16_t*)take((size_t)4352 * 1024 * 2); p.wt_in2 = (bf16_t*)take((size_t)2048 * 1024 * 2);
    p.wt_gv = (bf16_t*)take(2 * MiB); p.wt_dv = (bf16_t*)take(2 * MiB);
    p.wt_glao = (bf16_t*)take(2 * MiB); p.wt_diffo = (bf16_t*)take(2 * MiB); p.wt_out = (bf16_t*)take(2 * MiB);
    p.wt_up = (bf16_t*)take((size_t)5632 * 1024 * 2); p.wt_down = (bf16_t*)take((size_t)1024 * 2816 * 2);
    p.mod = (float*)take(8 * 6144 * 4);
    off = 40 * MiB;
    p.h = (bf16_t*)take(64 * MiB);
    char* big = ws + off;
    p.gq = (bf16_t*)(big); p.gk = (bf16_t*)(big + 32 * MiB); p.gg = (bf16_t*)(big + 64 * MiB); p.gvT = (bf16_t*)(big + 128 * MiB);
    p.acode = (float*)(big + 192 * MiB); p.decay = (float*)(big + 194 * MiB); p.delta = (bf16_t*)(big + 195 * MiB);
    p.dq = (bf16_t*)(big); p.dk = (bf16_t*)(big + 128 * MiB); p.dvT = (bf16_t*)(big + 195 * MiB); p.merged = (bf16_t*)(big + 259 * MiB);
    p.uh = (bf16_t*)(big); p.act = (bf16_t*)(big + 176 * MiB);
    p.sga = (bf16_t*)d_out; p.sgb = (bf16_t*)d_out + (size_t)T * 1024;
    if (ws_size < 456 * MiB) { fprintf(stderr, "workspace too small: %zu\n", ws_size); return; }

    const int G = 256;
    const size_t LDSB = 64 * 1024;
    k_phase<0><<<G, 512, LDSB, stream>>>(p, 0);
    k_phase<1><<<G, 512, LDSB, stream>>>(p, 0);
    naive_gemm<<<dim3(4352 / 64, T / 64), 256, 0, stream>>>(LA_bf16{p.h, 1024, 0}, LB_w{p.w_in, NIN, 0, 0, 0}, EpiP1{p}, 1024);
    naive_gemm<<<dim3(T / 64, 1024 / 64), 256, 0, stream>>>(LA_wT{p.w_in, NIN, 1024}, LB_hT{p.h}, EpiVT{p.gvT}, 1024);
    static bool attr = false;
    if (!attr) {
        (void)hipFuncSetAttribute((const void*)naive_g1, hipFuncAttributeMaxDynamicSharedMemorySize, 160 * 1024);
        (void)hipFuncSetAttribute((const void*)naive_g3, hipFuncAttributeMaxDynamicSharedMemorySize, 160 * 1024);
        (void)hipFuncSetAttribute((const void*)naive_attn, hipFuncAttributeMaxDynamicSharedMemorySize, 160 * 1024);
        attr = true;
    }
    naive_g1<<<2048, 256, (2 * 64 * 129 + 1024 + 2048) * 4, stream>>>(p);
    k_phase<4><<<G, 512, LDSB, stream>>>(p, 0);
    naive_g3<<<2048, 256, (3 * 64 * 129 + 64 * 65 + 1024 + 2048 + 64) * 4, stream>>>(p);
    naive_gemm<<<dim3(2048 / 64, T / 64), 256, 0, stream>>>(LA_bf16{p.h, 1024, 0}, LB_w{p.w_in, NIN, 1, 0, 0}, EpiP2{p}, 1024);
    naive_gemm<<<dim3(T / 64, 1024 / 64), 256, 0, stream>>>(LA_wT{p.w_in, NIN, 5136}, LB_hT{p.h}, EpiVT{p.dvT}, 1024);
    naive_attn<<<dim3(64, 64), 256, (4 * 64 * 65 + 64 * 128) * 4, stream>>>(p);
    naive_gemm<<<dim3(1024 / 64, T / 64), 256, 0, stream>>>(LA_bf16{p.gg, 1024, 0}, LB_w{p.w_gla_o, 1024, 4, 0, 0}, EpiM1{p}, 1024);
    naive_gemm<<<dim3(1024 / 64, T / 64), 256, 0, stream>>>(LA_bf16{p.dq, 1024, 0}, LB_w{p.w_diff_o, 1024, 4, 0, 0}, EpiMG{p}, 1024);
    naive_gemm<<<dim3(1024 / 64, T / 64), 256, 0, stream>>>(LA_bf16{p.merged, 1024, 0}, LB_w{p.w_out, 1024, 4, 0, 0}, EpiRes{p, p.x, p.out, 2048, 0}, 1024);
    k_phase<10><<<G, 512, LDSB, stream>>>(p, 0);
    for (int hf = 0; hf < 2; ++hf) {
        naive_gemm<<<dim3(2816 / 64, T / 64), 256, 0, stream>>>(LA_bf16{p.h, 1024, 0}, LB_w{p.w_up, 5632, 5, hf * 2816, 0}, EpiUp{p}, 1024);
        k_phase<12><<<G, 512, LDSB, stream>>>(p, hf);
    }
    naive_gemm<<<dim3(1024 / 64, T / 64), 256, 0, stream>>>(LA_bf16{p.act, 2816, 0}, LB_w{p.w_down, 1024, 4, 0, 0}, EpiRes{p, p.out, p.out, 5120, 0}, 2816);
}
```

```cpp
#include <hip/hip_runtime.h>
#include <hip/hip_cooperative_groups.h>
#include <cstdio>
namespace cg = cooperative_groups;

typedef unsigned short bf16_t;
typedef float f32x4 __attribute__((ext_vector_type(4)));
typedef unsigned u32x4 __attribute__((ext_vector_type(4)));
typedef unsigned u32x2 __attribute__((ext_vector_type(2)));

constexpr int T = 32768;
constexpr int DM = 1024;
constexpr int NIN = 8208;
constexpr float EPS = 1e-6f;
constexpr float LOG2E = 1.4426950408889634f;

__device__ __forceinline__ float bf2f(bf16_t v) { return __uint_as_float(((unsigned)v) << 16); }
__device__ __forceinline__ bf16_t f2bf(float f) { unsigned u = __float_as_uint(f); u += 0x7FFFu + ((u >> 16) & 1u); return (bf16_t)(u >> 16); }
typedef float f32x2v __attribute__((ext_vector_type(2)));
typedef __bf16 bf16x2v __attribute__((ext_vector_type(2)));
__device__ __forceinline__ unsigned pk2(float lo, float hi) { const f32x2v v = {lo, hi}; return __builtin_bit_cast(unsigned, __builtin_convertvector(v, bf16x2v)); }
__device__ __forceinline__ float siluf(float v) { return v * __builtin_amdgcn_rcpf(1.f + __builtin_amdgcn_exp2f(-LOG2E * v)); }
__device__ __forceinline__ float sigmf(float v) { return __builtin_amdgcn_rcpf(1.f + __builtin_amdgcn_exp2f(-LOG2E * v)); }
__device__ __forceinline__ float logsigf(float z) { return fminf(z, 0.f) - __logf(1.f + __expf(-fabsf(z))); }

__device__ __forceinline__ int otid() { int t = threadIdx.x; asm volatile("" : "+v"(t)); return t; }

struct P {
    const float *x, *c, *w_ada, *b_ada, *norm1_g, *w_in, *w_alpha_up, *b_alpha, *gla_norm_g, *q_norm_g, *k_norm_g,
        *lam_q1, *lam_k1, *lam_q2, *lam_k2, *diff_norm_g, *w_gla_o, *w_diff_o, *w_out, *norm2_g, *w_up, *conv_w, *conv_b, *w_down;
    float* out;
    bf16_t *wt_in1, *wt_in2, *wt_gv, *wt_dv, *wt_glao, *wt_diffo, *wt_out, *wt_up, *wt_down;
    float* mod;
    bf16_t* h;
    bf16_t *gq, *gk, *gg, *gvT;
    float *acode, *decay;
    bf16_t* delta;
    bf16_t *dq, *dk, *dvT, *merged, *uh, *act;
    bf16_t *sga, *sgb;
    unsigned* ctr;
    bf16_t* ubnd;
    bf16_t *kdtA, *kdtB; float* decg;
    bf16_t* x1b;
};

__host__ __device__ __forceinline__ int tperm(int q, int style) {
    const int bj = q >> 7, wc = (q >> 5) & 3, n = (q >> 4) & 1, fq = (q >> 2) & 3, j = q & 3;
    return style == 0 ? 64 * wc + 32 * bj + 8 * fq + 4 * n + j : 64 * wc + 16 * (2 * bj + n) + 4 * fq + j;
}
__host__ __device__ __forceinline__ int src_logical(int kind, int L) {
    switch (kind) {
        case 0:
            if (L < 1024) return L;
            if (L < 2048) return 2048 + (L - 1024);
            if (L < 3072) return 6160 + (L - 2048);
            if (L < 4096) return 7184 + (L - 3072);
            return (L - 4096) < 16 ? 3072 + (L - 4096) : -1;
        case 1:
            return L < 1024 ? 3088 + L : 4112 + (L - 1024);
        case 4: case 6: return L;
        case 5: { const int ch = 128 * (L >> 8) + ((L & 255) >> 1); return (L & 1) * 2816 + ch; }
    }
    return -1;
}
__host__ __device__ __forceinline__ int src_physical(int kind, int prow) {
    if (kind == 2) return 1024 + prow;
    if (kind == 3) return 5136 + prow;
    return src_logical(kind, (prow & ~255) + tperm(prow & 255, kind == 6 ? 1 : 0));
}

struct RedNaive { static __device__ __forceinline__ float sum4(float x) { x += __shfl_xor(x, 1); x += __shfl_xor(x, 2); return x; } };
struct RedFast  { static __device__ __forceinline__ float sum4(float x) { x += __shfl_xor(x, 16); x += __shfl_xor(x, 32); return x; } };

__device__ __forceinline__ void st16_bf16(bf16_t* dst, const float (&v)[16]) {
    u32x4 a, b;
    a.x = pk2(v[0], v[1]); a.y = pk2(v[2], v[3]); a.z = pk2(v[4], v[5]); a.w = pk2(v[6], v[7]);
    b.x = pk2(v[8], v[9]); b.y = pk2(v[10], v[11]); b.z = pk2(v[12], v[13]); b.w = pk2(v[14], v[15]);
    *(u32x4*)dst = a; *(u32x4*)(dst + 8) = b;
}
__device__ __forceinline__ void st8x2_bf16(bf16_t* dst, const float (&v)[16]) {
    u32x4 a, b;
    a.x = pk2(v[0], v[1]); a.y = pk2(v[2], v[3]); a.z = pk2(v[4], v[5]); a.w = pk2(v[6], v[7]);
    b.x = pk2(v[8], v[9]); b.y = pk2(v[10], v[11]); b.z = pk2(v[12], v[13]); b.w = pk2(v[14], v[15]);
    *(u32x4*)dst = a; *(u32x4*)(dst + 32) = b;
}
__device__ __forceinline__ void ld16_bf16(const bf16_t* src, float (&v)[16]) {
    const u32x4 a = *(const u32x4*)src, b = *(const u32x4*)(src + 8);
    const unsigned w[8] = {a.x, a.y, a.z, a.w, b.x, b.y, b.z, b.w};
#pragma unroll
    for (int i = 0; i < 8; ++i) { v[2 * i] = __uint_as_float(w[i] << 16); v[2 * i + 1] = __uint_as_float(w[i] & 0xFFFF0000u); }
}

__device__ __forceinline__ void unpack16(const u32x4& a, const u32x4& b, float (&v)[16]) {
    const unsigned w[8] = {a.x, a.y, a.z, a.w, b.x, b.y, b.z, b.w};
#pragma unroll
    for (int i = 0; i < 8; ++i) { v[2 * i] = __uint_as_float(w[i] << 16); v[2 * i + 1] = __uint_as_float(w[i] & 0xFFFF0000u); }
}
struct NoCtx {};
struct EpiP1 {
    static constexpr int STYLE = 0;
    P p;
    typedef NoCtx Ctx; typedef NoCtx Pre;
    __device__ __forceinline__ void begin(int seg, int c16, Ctx&) const {}
    __device__ __forceinline__ void pre(int seg, int row, int c16, Pre&) const {}
    __device__ __forceinline__ void fin(int seg, int row, int c16, float (&v)[16], const Pre&, const Ctx&) const {
        if (seg < 2) { st8x2_bf16(p.gq + (size_t)row * 512 + c16, v); }
        else if (seg < 4) { st8x2_bf16(p.gk + (size_t)row * 512 + (c16 - 512), v); }
        else if (seg < 8) {
#pragma unroll
            for (int i = 0; i < 16; ++i) v[i] = siluf(v[i]);
            st8x2_bf16(p.gg + (size_t)row * 1024 + (c16 - 1024), v);
        } else if (seg < 16) {
#pragma unroll
            for (int i = 0; i < 16; ++i) v[i] = sigmf(v[i]);
            bf16_t* dst = seg < 12 ? p.sga + (size_t)row * 1024 + (c16 - 2048) : p.sgb + (size_t)row * 1024 + (c16 - 3072);
            st8x2_bf16(dst, v);
        } else if (c16 == 4096 || c16 == 4104) {
            float* dst = p.acode + (size_t)row * 16 + (c16 - 4096);
            *(f32x4*)dst = (f32x4){v[0], v[1], v[2], v[3]}; *(f32x4*)(dst + 4) = (f32x4){v[4], v[5], v[6], v[7]};
        }
    }
};
struct EpiP2 {
    static constexpr int STYLE = 0;
    P p;
    struct Ctx { float g[16]; };
    typedef NoCtx Pre;
    __device__ __forceinline__ void begin(int seg, int c16, Ctx& c) const {
        const float* g = (seg < 4 ? p.q_norm_g : p.k_norm_g) + (c16 & 63); const float sc = seg < 4 ? 0.125f * LOG2E : 1.f;
#pragma unroll
        for (int i = 0; i < 8; ++i) { c.g[i] = g[i] * sc; c.g[8 + i] = g[32 + i] * sc; }
    }
    __device__ __forceinline__ void pre(int seg, int row, int c16, Pre&) const {}
    __device__ __forceinline__ void fin(int seg, int row, int c16, float (&v)[16], const Pre&, const Ctx& c) const {
        float ss = 0.f;
#pragma unroll
        for (int i = 0; i < 16; ++i) ss += v[i] * v[i];
        ss = RedFast::sum4(ss);
        const float rstd = rsqrtf(ss * (1.f / 64.f) + EPS);
#pragma unroll
        for (int i = 0; i < 16; ++i) v[i] = v[i] * rstd * c.g[i];
        bf16_t* dst = seg < 4 ? p.dq + (size_t)row * 1024 + c16 : p.dk + (size_t)row * 1024 + (c16 - 1024);
        st8x2_bf16(dst, v);
    }
};
struct EpiM1 {
    static constexpr int STYLE = 0;
    P p;
    typedef NoCtx Ctx; struct Pre { u32x4 a, b; };
    __device__ __forceinline__ void begin(int seg, int c16, Ctx&) const {}
    __device__ __forceinline__ void pre(int seg, int row, int c16, Pre& q) const { const bf16_t* s = p.sga + (size_t)row * 1024 + c16; q.a = __builtin_nontemporal_load((const u32x4*)s); q.b = __builtin_nontemporal_load((const u32x4*)(s + 32)); }
    __device__ __forceinline__ void fin(int seg, int row, int c16, float (&v)[16], const Pre& q, const Ctx&) const {
        float g[16]; unpack16(q.a, q.b, g);
#pragma unroll
        for (int i = 0; i < 16; ++i) v[i] *= g[i];
        st8x2_bf16(p.merged + (size_t)row * 1024 + c16, v);
    }
};
struct EpiMG {
    static constexpr int STYLE = 0;
    P p;
    typedef NoCtx Ctx; struct Pre { u32x4 a, b, c, d; };
    __device__ __forceinline__ void begin(int seg, int c16, Ctx&) const {}
    __device__ __forceinline__ void pre(int seg, int row, int c16, Pre& q) const {
        const bf16_t* s = p.sgb + (size_t)row * 1024 + c16; const bf16_t* m = p.merged + (size_t)row * 1024 + c16;
        q.a = __builtin_nontemporal_load((const u32x4*)s); q.b = __builtin_nontemporal_load((const u32x4*)(s + 32)); q.c = __builtin_nontemporal_load((const u32x4*)m); q.d = __builtin_nontemporal_load((const u32x4*)(m + 32));
    }
    __device__ __forceinline__ void fin(int seg, int row, int c16, float (&v)[16], const Pre& q, const Ctx&) const {
        float g[16], m[16]; unpack16(q.a, q.b, g); unpack16(q.c, q.d, m);
#pragma unroll
        for (int i = 0; i < 16; ++i) v[i] = m[i] + g[i] * v[i];
        st8x2_bf16(p.merged + (size_t)row * 1024 + c16, v);
    }
};
struct EpiRes {
    static constexpr int STYLE = 1;
    P p; const float* src; float* dst; int goff; int pad;
    struct Ctx { f32x4 g[4]; }; struct Pre { f32x4 x[4]; };
    __device__ __forceinline__ void begin(int seg, int c16, Ctx&) const {}
    __device__ __forceinline__ void pre(int seg, int row, int c16, Pre& q) const {
        const float* s = src + (size_t)row * 1024 + c16;
#pragma unroll
        for (int i = 0; i < 4; ++i) q.x[i] = *(const f32x4*)(s + 16 * i);
    }
    __device__ __forceinline__ void fin(int seg, int row, int c16, float (&v)[16], const Pre& q, const Ctx&) const {
        const float* gt = p.mod + (size_t)(row >> 12) * 6144 + goff + c16;
        float* d = dst + (size_t)row * 1024 + c16;
#pragma unroll
        for (int i = 0; i < 4; ++i) {
            const f32x4 gv = *(const f32x4*)(gt + 16 * i);
            f32x4 o; o.x = q.x[i].x + gv.x * v[4 * i]; o.y = q.x[i].y + gv.y * v[4 * i + 1]; o.z = q.x[i].z + gv.z * v[4 * i + 2]; o.w = q.x[i].w + gv.w * v[4 * i + 3];
            *(f32x4*)(d + 16 * i) = o;
        }
    }
};
struct EpiX1 {
    static constexpr int STYLE = 0;
    P p;
    typedef NoCtx Ctx; struct Pre { f32x4 x[4]; };
    __device__ __forceinline__ void begin(int seg, int c16, Ctx&) const {}
    __device__ __forceinline__ void pre(int seg, int row, int c16, Pre& q) const {
        const float* s = p.x + (size_t)row * 1024 + c16;
        q.x[0] = __builtin_nontemporal_load((const f32x4*)s); q.x[1] = __builtin_nontemporal_load((const f32x4*)(s + 4)); q.x[2] = __builtin_nontemporal_load((const f32x4*)(s + 32)); q.x[3] = __builtin_nontemporal_load((const f32x4*)(s + 36));
    }
    __device__ __forceinline__ void fin(int seg, int row, int c16, float (&v)[16], const Pre& q, const Ctx&) const {
        const float* gt = p.mod + (size_t)(row >> 12) * 6144 + 2048 + c16;
#pragma unroll
        for (int i = 0; i < 4; ++i) {
            const f32x4 gv = *(const f32x4*)(gt + (i >> 1) * 32 + (i & 1) * 4);
            v[4 * i] = q.x[i].x + gv.x * v[4 * i]; v[4 * i + 1] = q.x[i].y + gv.y * v[4 * i + 1]; v[4 * i + 2] = q.x[i].z + gv.z * v[4 * i + 2]; v[4 * i + 3] = q.x[i].w + gv.w * v[4 * i + 3];
        }
        st8x2_bf16(p.x1b + (size_t)row * 1024 + c16, v);
    }
};
struct EpiOut {
    static constexpr int STYLE = 1;
    P p;
    typedef NoCtx Ctx; struct Pre { u32x2 x[4]; };
    __device__ __forceinline__ void begin(int seg, int c16, Ctx&) const {}
    __device__ __forceinline__ void pre(int seg, int row, int c16, Pre& q) const {
        const bf16_t* s = p.x1b + (size_t)row * 1024 + c16;
#pragma unroll
        for (int i = 0; i < 4; ++i) q.x[i] = __builtin_nontemporal_load((const u32x2*)(s + 16 * i));
    }
    __device__ __forceinline__ void fin(int seg, int row, int c16, float (&v)[16], const Pre& q, const Ctx&) const {
        const float* gt = p.mod + (size_t)(row >> 12) * 6144 + 5120 + c16;
        float* d = p.out + (size_t)row * 1024 + c16;
#pragma unroll
        for (int i = 0; i < 4; ++i) {
            const f32x4 gv = *(const f32x4*)(gt + 16 * i);
            f32x4 o;
            o.x = __uint_as_float(q.x[i].x << 16) + gv.x * v[4 * i]; o.y = __uint_as_float(q.x[i].x & 0xFFFF0000u) + gv.y * v[4 * i + 1];
            o.z = __uint_as_float(q.x[i].y << 16) + gv.z * v[4 * i + 2]; o.w = __uint_as_float(q.x[i].y & 0xFFFF0000u) + gv.w * v[4 * i + 3];
            *(f32x4*)(d + 16 * i) = o;
        }
    }
};
struct EpiUp {
    static constexpr int STYLE = 0;
    P p;
    typedef NoCtx Ctx; typedef NoCtx Pre;
    __device__ __forceinline__ void begin(int seg, int c16, Ctx&) const {}
    __device__ __forceinline__ void pre(int seg, int row, int c16, Pre&) const {}
    __device__ __forceinline__ void fin(int seg, int row, int c16, float (&v)[16], const Pre&, const Ctx&) const { st8x2_bf16(p.uh + (size_t)row * 2816 + c16, v); }
};

namespace pg8 {
#define PG8_LAS __attribute__((address_space(3)))
typedef unsigned short bf16_t;
typedef short bf16x8 __attribute__((ext_vector_type(8)));
typedef float f32x4 __attribute__((ext_vector_type(4)));
typedef unsigned u32x4 __attribute__((ext_vector_type(4)));
constexpr int BM = 256, BK = 64, HALF = 128, HTB = HALF * BK * 2  , STAGE_BYTES = 8 * HTB, NXCD = 8, WGM = 8;

__host__ __device__ __forceinline__ int lds_byte(int r, int c) { const int st = (r >> 4) * 2 + (c >> 5), rr = r & 15, cc = c & 31, ob = rr * 64 + cc * 2; return st * 1024 + (ob ^ (((ob >> 9) & 1) << 5)); }
__host__ __device__ __forceinline__ void stage_rc(int b, int& R, int& C) { const int st = b / 1024, sb = b % 1024, swz = sb ^ (((sb >> 9) & 1) << 5); R = (st >> 1) * 16 + swz / 64; C = (st & 1) * 32 + (swz % 64) / 2; }
__host__ __device__ __forceinline__ int perm32(int rho) { const int n = rho >> 4, i = rho & 15; return 8 * (i >> 2) + 4 * n + (i & 3); }

struct Unit { int pm, pn; };
struct Gemm { const bf16_t* A; const bf16_t* Bt; int M, N, K; };

struct StaticOrder {
    int nM, nN, nwg, G, c;
    __host__ __device__ void init(int M, int N, int G_, int c_) { nM = M / BM; nN = N / BM; nwg = nM * nN; G = G_; c = c_; }
    __host__ __device__ bool next(int i, Unit& u) const {
        const long L = (long)i * G + c; if (L >= nwg) return false;
        int wgid = (int)L; { const int q = nwg / NXCD, r = nwg % NXCD, xcd = wgid % NXCD, off = wgid / NXCD; wgid = (xcd < r ? xcd * (q + 1) : r * (q + 1) + (xcd - r) * q) + off; }
        const int nig = WGM * nN, gid = wgid / nig, fm = gid * WGM, gsz = (nM - fm) < WGM ? (nM - fm) : WGM;
        u.pm = fm + ((wgid % nig) % gsz); u.pn = (wgid % nig) / gsz; return true;
    }
    __device__ __forceinline__ void a_ready(const Unit&) const {}
    __device__ __forceinline__ void done(const Unit&) const {}
};

template <class Epi, class Sched, bool STAMP = false>
__device__ __forceinline__ void gemm_phase(PG8_LAS unsigned char* lds, const Gemm g, const Sched& S, const Epi& E, unsigned long long* stamps) {
    int tid_ = threadIdx.x; asm volatile("" : "+v"(tid_));
    const int tid = tid_, wid = __builtin_amdgcn_readfirstlane(tid >> 6), lane = tid & 63, wr = wid >> 2, wc = wid & 3, fr = lane & 15, fq = lane >> 4;
    const int K = g.K, nt = K / BK;
    int ts_lo = 0, ts_hi = 0, nts = 0; const unsigned long long rt_entry = STAMP ? (unsigned long long)wall_clock64() : 0ull;
#define PG8_STAMP() do { if (STAMP && wid == 0 && nts < 64) { const unsigned long long _c = (unsigned long long)clock64(); \
        ts_lo = (lane == nts) ? (int)(unsigned)_c : ts_lo; ts_hi = (lane == nts) ? (int)(unsigned)(_c >> 32) : ts_hi; ++nts; } } while (0)
    PG8_STAMP();
    unsigned voffA[2], voffB[2];
#pragma unroll
    for (int i = 0; i < 2; ++i) { int R, C; stage_rc(tid * 16 + i * 8192, R, C); const int Rb = Epi::PERM ? ((R & ~31) + perm32(R & 31)) : R;
        voffA[i] = (unsigned)(R * K + C) * 2u; voffB[i] = (unsigned)(Rb * K + C) * 2u; }
    const size_t kstep = (size_t)(BK * 2);
    const size_t hstep = (size_t)HALF * K * 2;
    const size_t tstep = 2 * hstep;
    const unsigned ldsw = (unsigned)wid * 1024u;
    const int aoff = lds_byte(wr * 64 + fr, fq * 8), boff = lds_byte(wc * 32 + fr, fq * 8);
#define PG8_SA(b, h) (((b) * 2 + (h)) * HTB)
#define PG8_SB(b, h) ((4 + (b) * 2 + (h)) * HTB)
#define PG8_STAGE(bufoff, gbase, voff) do { _Pragma("unroll") for (int _i = 0; _i < 2; ++_i) \
        __builtin_amdgcn_global_load_lds((const unsigned*)((const char*)(gbase) + (voff)[_i]), (PG8_LAS unsigned*)(lds + (bufoff) + ldsw + _i * 8192), 16, 0, 0); } while (0)
#define PG8_LDA(dst, b, h) do { _Pragma("unroll") for (int m = 0; m < 4; ++m) _Pragma("unroll") for (int k = 0; k < 2; ++k) dst[m][k] = *(const PG8_LAS bf16x8*)(lds + PG8_SA(b, h) + aoff + m * 2048 + k * 1024); } while (0)
#define PG8_LDB(dst, b, h) do { _Pragma("unroll") for (int n = 0; n < 2; ++n) _Pragma("unroll") for (int k = 0; k < 2; ++k) dst[n][k] = *(const PG8_LAS bf16x8*)(lds + PG8_SB(b, h) + boff + n * 2048 + k * 1024); } while (0)
#define PG8_MMA(ai, bj, At, Bt) do { __builtin_amdgcn_s_setprio(1); _Pragma("unroll") for (int m = 0; m < 4; ++m) _Pragma("unroll") for (int n = 0; n < 2; ++n) _Pragma("unroll") for (int k = 0; k < 2; ++k) \
        acc[ai][bj][m][n] = __builtin_amdgcn_mfma_f32_16x16x32_bf16(Bt[n][k], At[m][k], acc[ai][bj][m][n], 0, 0, 0); __builtin_amdgcn_s_setprio(0); } while (0)
#define PG8_WAIT_V(n) asm volatile("s_waitcnt vmcnt(" #n ")" ::: "memory")
#define PG8_WAIT_L(n) asm volatile("s_waitcnt lgkmcnt(" #n ")" ::: "memory")
#define PG8_BAR __builtin_amdgcn_s_barrier()
#define PG8_SCHED __builtin_amdgcn_sched_barrier(0)
    Unit cur, nxt; int ui = 0;
    if (!S.next(0, cur)) return;
    f32x4 acc[2][2][4][2];
#pragma unroll
    for (int a = 0; a < 2; ++a)
#pragma unroll
        for (int b = 0; b < 2; ++b)
#pragma unroll
            for (int m = 0; m < 4; ++m)
#pragma unroll
                for (int n = 0; n < 2; ++n) acc[a][b][m][n] = (f32x4){0.f, 0.f, 0.f, 0.f};
    bf16x8 At[4][2], B0[2][2], B1[2][2];
    const char* cA = (const char*)g.A + (size_t)cur.pm * tstep; const char* cB = (const char*)g.Bt + (size_t)cur.pn * tstep;
    S.a_ready(cur);
    PG8_STAGE(PG8_SB(0, 0), cB, voffB); PG8_STAGE(PG8_SA(0, 0), cA, voffA); PG8_STAGE(PG8_SB(0, 1), cB + hstep, voffB); PG8_STAGE(PG8_SA(0, 1), cA + hstep, voffA);
    if (wr == 1) PG8_BAR;
    PG8_WAIT_V(4); PG8_BAR;
    PG8_STAGE(PG8_SB(1, 0), cB + kstep, voffB); PG8_STAGE(PG8_SA(1, 0), cA + kstep, voffA); PG8_STAGE(PG8_SB(1, 1), cB + hstep + kstep, voffB);
    PG8_WAIT_V(6); PG8_BAR;
    PG8_STAMP();
#ifndef KREP
#define KREP 1
#endif
    int krep = 0;
    for (;;) {
        const bool adv = (krep == KREP - 1);
        bool has_next = true;
        if (adv) has_next = S.next(ui + 1, nxt); else nxt = cur;
        const char* nA = has_next ? (const char*)g.A + (size_t)nxt.pm * tstep : cA; const char* nB = has_next ? (const char*)g.Bt + (size_t)nxt.pn * tstep : cB;
        for (int t = 0; t < nt; t += 2) {
            const bool last = (t == nt - 2);
            const char* a1 = cA + (size_t)(t + 1) * kstep;
            const char* a2 = last ? nA : cA + (size_t)(t + 2) * kstep; const char* b2 = last ? nB : cB + (size_t)(t + 2) * kstep;
            const char* a3 = a2 + kstep; const char* b3 = b2 + kstep;
            if (last && has_next) S.a_ready(nxt);
            PG8_LDB(B0, 0, 0); PG8_SCHED; PG8_LDA(At, 0, 0); PG8_STAGE(PG8_SA(1, 1), a1 + hstep, voffA);
            PG8_WAIT_L(8); PG8_BAR; PG8_WAIT_L(0); PG8_MMA(0, 0, At, B0); PG8_BAR; PG8_SCHED;
            PG8_LDB(B1, 0, 1); PG8_STAGE(PG8_SB(0, 0), b2, voffB);
            PG8_BAR; PG8_WAIT_L(0); PG8_MMA(0, 1, At, B1); PG8_BAR;
            PG8_LDA(At, 0, 1); PG8_STAGE(PG8_SA(0, 0), a2, voffA);
            PG8_BAR; PG8_WAIT_L(0); PG8_MMA(1, 0, At, B0); PG8_BAR; PG8_SCHED;
            PG8_STAGE(PG8_SB(0, 1), b2 + hstep, voffB);
            PG8_WAIT_V(6); PG8_BAR; PG8_MMA(1, 1, At, B1); PG8_BAR;
            PG8_LDB(B0, 1, 0); PG8_SCHED; PG8_LDA(At, 1, 0); PG8_STAGE(PG8_SA(0, 1), a2 + hstep, voffA);
            PG8_WAIT_L(8); PG8_BAR; PG8_WAIT_L(0); PG8_MMA(0, 0, At, B0); PG8_BAR; PG8_SCHED;
            PG8_LDB(B1, 1, 1); PG8_STAGE(PG8_SB(1, 0), b3, voffB);
            PG8_BAR; PG8_WAIT_L(0); PG8_MMA(0, 1, At, B1); PG8_BAR;
            PG8_LDA(At, 1, 1); PG8_STAGE(PG8_SA(1, 0), a3, voffA);
            PG8_BAR; PG8_WAIT_L(0); PG8_MMA(1, 0, At, B0); PG8_BAR; PG8_SCHED;
            PG8_STAGE(PG8_SB(1, 1), b3 + hstep, voffB);
            PG8_WAIT_V(6); PG8_BAR; PG8_MMA(1, 1, At, B1); PG8_BAR;
        }
        PG8_STAMP();
        if (!adv) {
            ++krep;
#pragma unroll
            for (int a = 0; a < 2; ++a)
#pragma unroll
                for (int b = 0; b < 2; ++b)
#pragma unroll
                    for (int m = 0; m < 4; ++m)
#pragma unroll
                        for (int n = 0; n < 2; ++n) acc[a][b][m][n] = (f32x4){0.f, 0.f, 0.f, 0.f};
            continue;
        }
        krep = 0;
        if constexpr (!Epi::AFTER_DRAIN) { E(acc, cur, wr, wc, fr, fq); S.done(cur); }
        PG8_STAMP();
        if (!has_next) break;
#pragma unroll
        for (int a = 0; a < 2; ++a)
#pragma unroll
            for (int b = 0; b < 2; ++b)
#pragma unroll
                for (int m = 0; m < 4; ++m)
#pragma unroll
                    for (int n = 0; n < 2; ++n) acc[a][b][m][n] = (f32x4){0.f, 0.f, 0.f, 0.f};
        cur = nxt; cA = nA; cB = nB; ++ui;
    }
    PG8_WAIT_V(0);
    if (wr == 0) PG8_BAR;
    PG8_BAR;
    if constexpr (Epi::AFTER_DRAIN) { E.fused(acc, cur, wr, wc, fr, fq, lds, wid, lane); S.done(cur); }
    PG8_STAMP();
    if (STAMP && wid == 0) { stamps[lane] = lane < nts ? (((unsigned long long)(unsigned)ts_hi << 32) | (unsigned)ts_lo) : 0ull;
        if (lane == 62) stamps[62] = rt_entry; if (lane == 63) stamps[63] = (unsigned long long)wall_clock64(); }
#undef PG8_STAMP
#undef PG8_SA
#undef PG8_SB
#undef PG8_STAGE
#undef PG8_LDA
#undef PG8_LDB
#undef PG8_MMA
#undef PG8_WAIT_V
#undef PG8_WAIT_L
#undef PG8_BAR
#undef PG8_SCHED
}
}


template <class EPI> struct FastEpi {
    static constexpr bool PERM = false, AFTER_DRAIN = false;
    EPI e;
    __device__ __forceinline__ void operator()(const pg8::f32x4 (&acc)[2][2][4][2], const pg8::Unit& u, int wr, int wc, int fr, int fq) const {
        const int c16 = u.pn * 256 + 64 * wc + (EPI::STYLE == 0 ? 8 : 4) * fq, seg = u.pn;
        const int row0 = u.pm * 256 + wr * 64 + fr;
        typename EPI::Ctx ctx; e.begin(seg, c16, ctx);
        typename EPI::Pre pre[2][2];
        e.pre(seg, row0, c16, pre[0][0]); e.pre(seg, row0 + 16, c16, pre[0][1]);
#pragma unroll
        for (int bt = 0; bt < 4; ++bt) {
            if (bt < 3) {
                const int k = 2 * bt + 2;
                e.pre(seg, row0 + (k >> 2) * 128 + (k & 3) * 16, c16, pre[(bt + 1) & 1][0]); e.pre(seg, row0 + (k >> 2) * 128 + ((k + 1) & 3) * 16, c16, pre[(bt + 1) & 1][1]);
            }
#pragma unroll
            for (int r = 0; r < 2; ++r) {
                const int k = 2 * bt + r, ai = k >> 2, m = k & 3;
                float v[16];
#pragma unroll
                for (int bj = 0; bj < 2; ++bj)
#pragma unroll
                    for (int n = 0; n < 2; ++n)
#pragma unroll
                        for (int j = 0; j < 4; ++j) v[8 * bj + 4 * n + j] = acc[ai][bj][m][n][j];
                e.fin(seg, row0 + ai * 128 + m * 16, c16, v, pre[bt & 1][r], ctx);
            }
        }
    }
};
struct FastEpiUpConv {
    static constexpr bool PERM = false, AFTER_DRAIN = false;
    P p; char* xh;
    __device__ __forceinline__ void operator()(const pg8::f32x4 (&acc)[2][2][4][2], const pg8::Unit& u, int wr, int wc, int fr, int fq) const {
        const int lane = 16 * fq + fr;
        const int src1 = (lane & 48) | ((fr + 15) & 15), src2 = (lane & 48) | ((fr + 14) & 15);
        const int ch0 = 128 * u.pn + 32 * wc + 4 * fq;
        const int row0 = u.pm * 256 + wr * 64 + fr;
        float* xhf = (float*)xh;
        if (fr >= 14) {
#pragma unroll
            for (int ai = 0; ai < 2; ++ai) {
                float* d = xhf + ((((ai * 2 + wr) * 4 + wc) * 4 + fq) * 2 + (fr - 14)) * 16;
#pragma unroll
                for (int bj = 0; bj < 2; ++bj)
#pragma unroll
                    for (int n = 0; n < 2; ++n) *(f32x4*)(d + 8 * bj + 4 * n) = acc[ai][bj][3][n];
            }
        }
        {
            const bool top = (wr == 0 && fr < 2), bot = (wr == 1 && fr >= 14);
            if (top || bot) {
                const int ai = top ? 0 : 1, m = top ? 0 : 3, rsel = top ? fr : fr - 12;
                float v[16];
#pragma unroll
                for (int bj = 0; bj < 2; ++bj)
#pragma unroll
                    for (int n = 0; n < 2; ++n)
#pragma unroll
                        for (int j = 0; j < 4; ++j) v[8 * bj + 4 * n + j] = top ? acc[0][bj][0][n][j] : acc[1][bj][3][n][j];
                (void)ai; (void)m;
                st8x2_bf16(p.ubnd + ((size_t)u.pm * 4 + rsel) * 5632 + u.pn * 256 + 64 * wc + 8 * fq, v);
            }
        }
        asm volatile("s_waitcnt lgkmcnt(0)" ::: "memory");
        __builtin_amdgcn_s_barrier(); __builtin_amdgcn_s_barrier();
        asm volatile("" ::: "memory");
#pragma unroll
        for (int hf = 0; hf < 2; ++hf) {
            const int ch = ch0 + 16 * hf;
            float wa[3][4], wb[3][4], ba[4], bb[4];
#pragma unroll
            for (int j = 0; j < 3; ++j) {
                const f32x4 a = *(const f32x4*)(p.conv_w + j * 5632 + ch), b = *(const f32x4*)(p.conv_w + j * 5632 + 2816 + ch);
                wa[j][0] = a.x; wa[j][1] = a.y; wa[j][2] = a.z; wa[j][3] = a.w; wb[j][0] = b.x; wb[j][1] = b.y; wb[j][2] = b.z; wb[j][3] = b.w;
            }
            { const f32x4 a = *(const f32x4*)(p.conv_b + ch), b = *(const f32x4*)(p.conv_b + 2816 + ch); ba[0] = a.x; ba[1] = a.y; ba[2] = a.z; ba[3] = a.w; bb[0] = b.x; bb[1] = b.y; bb[2] = b.z; bb[3] = b.w; }
#pragma unroll
            for (int ai = 0; ai < 2; ++ai) {
                float t1p[8], t2p[8];
                {
                    const int pb = 2 * ai + wr - 1;
                    if (pb >= 0) {
                        const float* hsrc = xhf + (((pb * 4 + wc) * 4 + fq) * 2) * 16 + 8 * hf;
#pragma unroll
                        for (int k = 0; k < 8; ++k) { const float h2 = hsrc[k], h1 = hsrc[16 + k]; t1p[k] = h1; t2p[k] = fr == 0 ? h2 : h1; }
                    } else {
#pragma unroll
                        for (int k = 0; k < 8; ++k) { t1p[k] = 0.f; t2p[k] = 0.f; }
                    }
                }
#pragma unroll
                for (int m = 0; m < 4; ++m) {
                    float o[4];
#pragma unroll
                    for (int i = 0; i < 4; ++i) {
                        float cur[2], p1[2], p2[2];
#pragma unroll
                        for (int ab = 0; ab < 2; ++ab) {
                            const int k = 2 * i + ab;
                            const float v = acc[ai][hf][m][k >> 2][k & 3];
                            const float t1 = __shfl(v, src1), t2 = __shfl(v, src2);
                            cur[ab] = v; p1[ab] = fr == 0 ? t1p[k] : t1; p2[ab] = fr < 2 ? t2p[k] : t2;
                            t1p[k] = t1; t2p[k] = t2;
                        }
                        const float ca = wa[0][i] * p2[0] + wa[1][i] * p1[0] + wa[2][i] * cur[0] + ba[i];
                        const float cb = wb[0][i] * p2[1] + wb[1][i] * p1[1] + wb[2][i] * cur[1] + bb[i];
                        o[i] = siluf(ca) * cb;
                    }
                    u32x2 ov; ov.x = pk2(o[0], o[1]); ov.y = pk2(o[2], o[3]);
                    *(u32x2*)(p.act + (size_t)(row0 + ai * 128 + m * 16) * 2816 + ch) = ov;
                }
            }
        }
    }
};
__device__ __forceinline__ void fixup_phase(const P& p) {
    const int t_ = otid();
    for (int task = blockIdx.x * 512 + t_; task < 128 * 704; task += gridDim.x * 512) {
        const int pm = task / 704, rem = task % 704, rsel = rem / 352, cg = rem % 352;
        const int ch0 = cg * 8, col = (ch0 >> 7) * 256 + 2 * (ch0 & 127);
        float c0[16], c1[16], h1[16], h2[16];
        ld16_bf16(p.ubnd + ((size_t)pm * 4 + 0) * 5632 + col, c0); ld16_bf16(p.ubnd + ((size_t)pm * 4 + 1) * 5632 + col, c1);
        if (pm & 15) { ld16_bf16(p.ubnd + ((size_t)(pm - 1) * 4 + 3) * 5632 + col, h1); ld16_bf16(p.ubnd + ((size_t)(pm - 1) * 4 + 2) * 5632 + col, h2); }
        else {
#pragma unroll
            for (int k = 0; k < 16; ++k) { h1[k] = 0.f; h2[k] = 0.f; }
        }
        float o[8];
#pragma unroll
        for (int i = 0; i < 8; ++i) {
            const int ch = ch0 + i;
            const float a2 = rsel ? h1[2 * i] : h2[2 * i], a1 = rsel ? c0[2 * i] : h1[2 * i], a0 = rsel ? c1[2 * i] : c0[2 * i];
            const float b2 = rsel ? h1[2 * i + 1] : h2[2 * i + 1], b1 = rsel ? c0[2 * i + 1] : h1[2 * i + 1], b0 = rsel ? c1[2 * i + 1] : c0[2 * i + 1];
            const float ca = p.conv_w[ch] * a2 + p.conv_w[5632 + ch] * a1 + p.conv_w[2 * 5632 + ch] * a0 + p.conv_b[ch];
            const float cb = p.conv_w[2816 + ch] * b2 + p.conv_w[5632 + 2816 + ch] * b1 + p.conv_w[2 * 5632 + 2816 + ch] * b0 + p.conv_b[2816 + ch];
            o[i] = siluf(ca) * cb;
        }
        u32x4 ov; ov.x = pk2(o[0], o[1]); ov.y = pk2(o[2], o[3]); ov.z = pk2(o[4], o[5]); ov.w = pk2(o[6], o[7]);
        *(u32x4*)(p.act + ((size_t)pm * 256 + rsel) * 2816 + ch0) = ov;
    }
}
struct FastEpiVT {
    static constexpr bool PERM = false, AFTER_DRAIN = false, PROBE_TWICE = false;
    bf16_t* gdst; bf16_t* ddst;
    __device__ __forceinline__ void operator()(const pg8::f32x4 (&acc)[2][2][4][2], const pg8::Unit& u, int wr, int wc, int fr, int fq) const {
        const bool gla = u.pm < 4;
#pragma unroll
        for (int ai = 0; ai < 2; ++ai)
#pragma unroll
            for (int m = 0; m < 4; ++m) {
                const size_t row = (size_t)((u.pm & 3) * 256 + ai * 128 + wr * 64 + m * 16 + fr);
#pragma unroll
                for (int bj = 0; bj < 2; ++bj)
#pragma unroll
                    for (int n = 0; n < 2; ++n) {
                        const int col = u.pn * 256 + bj * 128 + wc * 32 + n * 16 + 4 * fq;
                        u32x2 o; o.x = pk2(acc[ai][bj][m][n][0], acc[ai][bj][m][n][1]); o.y = pk2(acc[ai][bj][m][n][2], acc[ai][bj][m][n][3]);
                        bf16_t* dst = gla ? gdst + ((size_t)(col >> 6) * 65536 + row * 64 + (col & 63)) : ddst + (row * T + col);
                        *(u32x2*)dst = o;
                    }
            }
    }
};
template <class FE> __device__ __forceinline__ void run_gemm(char* shm, const bf16_t* A, const bf16_t* Bt, int M, int N, int K, const FE& fe) {
    int c_ = (int)blockIdx.x; asm volatile("" : "+s"(c_));
    pg8::StaticOrder S; S.init(M, N, (int)gridDim.x, c_);
    pg8::gemm_phase<FE, pg8::StaticOrder, false>((PG8_LAS unsigned char*)shm, pg8::Gemm{A, Bt, M, N, K}, S, fe, nullptr);
}

__device__ __forceinline__ void phase_mod(const P& p, float* lds) {
    float* sc = lds; float* red = lds + 8192;
    const int t = otid();
    bool ready = false;
    for (int item = gridDim.x - 1 - blockIdx.x; item < 192; item += gridDim.x) {
        if (!ready) { for (int i = t; i < 8192; i += 512) sc[i] = siluf(p.c[i]); ready = true; __syncthreads(); }
        const int cl = t & 31, ks = t >> 5, col = item * 32 + cl;
        float acc[8];
#pragma unroll
        for (int b = 0; b < 8; ++b) acc[b] = 0.f;
#pragma unroll 8
        for (int k = ks * 64; k < ks * 64 + 64; ++k) {
            const float w = p.w_ada[(size_t)k * 6144 + col];
#pragma unroll
            for (int b = 0; b < 8; ++b) acc[b] += sc[b * 1024 + k] * w;
        }
#pragma unroll
        for (int b = 0; b < 8; ++b) red[(ks * 8 + b) * 32 + cl] = acc[b];
        __syncthreads();
        if (t < 256) {
            const int b = t >> 5, cc = t & 31; float s = 0.f;
#pragma unroll
            for (int k2 = 0; k2 < 16; ++k2) s += red[(k2 * 8 + b) * 32 + cc];
            p.mod[b * 6144 + item * 32 + cc] = s + p.b_ada[item * 32 + cc];
        }
        __syncthreads();
    }
}
__device__ __forceinline__ void convert_one(const float* W, int ldw, int K, bf16_t* dst, int nrows, int kind, float* lds, int& rot) {
    const int ntk = K / 64, nt = (nrows / 64) * ntk, G = gridDim.x, t = otid();
    int first = (int)blockIdx.x + G - rot; if (first >= G) first -= G;
    for (int tile = first; tile < nt; tile += G) {
        const int tr = tile / ntk, k0 = (tile % ntk) * 64;
        const int pbase = (tr >> 2) * 256 + (tr & 3) * 32;
#define CONV_PROW(pp) (pbase + ((pp) >> 5) * 128 + ((pp) & 31))
        {
            const int pp = t & 63, kq = t >> 6; const int s = src_physical(kind, CONV_PROW(pp));
#pragma unroll
            for (int i = 0; i < 8; ++i) { const int kk = kq + 8 * i; lds[kk * 65 + pp] = s < 0 ? 0.f : W[(size_t)(k0 + kk) * ldw + s]; }
        }
        __syncthreads();
        {
            const int pp = t >> 3, ks = (t & 7) * 8; u32x4 o;
            o.x = pk2(lds[(ks + 0) * 65 + pp], lds[(ks + 1) * 65 + pp]); o.y = pk2(lds[(ks + 2) * 65 + pp], lds[(ks + 3) * 65 + pp]);
            o.z = pk2(lds[(ks + 4) * 65 + pp], lds[(ks + 5) * 65 + pp]); o.w = pk2(lds[(ks + 6) * 65 + pp], lds[(ks + 7) * 65 + pp]);
            *(u32x4*)(dst + (size_t)CONV_PROW(pp) * K + k0 + ks) = o;
        }
        __syncthreads();
    }
    rot += nt; while (rot >= G) rot -= G;
}
__device__ __forceinline__ void phase_convert(const P& p, float* lds) {
    int rot = 0;
    convert_one(p.w_in, NIN, 1024, p.wt_in1, 4352, 0, lds, rot);
    convert_one(p.w_in, NIN, 1024, p.wt_in2, 2048, 1, lds, rot);
    convert_one(p.w_in, NIN, 1024, p.wt_gv, 1024, 2, lds, rot);
    convert_one(p.w_in, NIN, 1024, p.wt_dv, 1024, 3, lds, rot);
    convert_one(p.w_gla_o, 1024, 1024, p.wt_glao, 1024, 4, lds, rot);
    convert_one(p.w_diff_o, 1024, 1024, p.wt_diffo, 1024, 4, lds, rot);
    convert_one(p.w_out, 1024, 1024, p.wt_out, 1024, 4, lds, rot);
    convert_one(p.w_up, 5632, 1024, p.wt_up, 5632, 5, lds, rot);
    convert_one(p.w_down, 1024, 2816, p.wt_down, 1024, 6, lds, rot);
}

__device__ __forceinline__ void phase_norm(const P& p, const float* src, const float* g, int sh_off, int sc_off, bf16_t* dst) {
    const int t_ = otid(), lane = t_ & 63, w = t_ >> 6;
    for (int vb = blockIdx.x; vb < 256; vb += gridDim.x) {
        const int b = vb >> 5;
        const float* md = p.mod + (size_t)b * 6144;
        f32x4 gs[4], sh[4];
#pragma unroll
        for (int i = 0; i < 4; ++i) {
            const int e = i * 256 + lane * 4;
            const f32x4 gg = *(const f32x4*)(g + e), sc = *(const f32x4*)(md + sc_off + e);
            gs[i] = gg * (sc + 1.f); sh[i] = *(const f32x4*)(md + sh_off + e);
        }
        for (int rr = 0; rr < 4; ++rr) {
            f32x4 xv[4][4]; float ss[4];
#pragma unroll
            for (int q = 0; q < 4; ++q) {
                const size_t row = (size_t)vb * 128 + w + 8 * (4 * rr + q);
                ss[q] = 0.f;
#pragma unroll
                for (int i = 0; i < 4; ++i) xv[q][i] = __builtin_nontemporal_load((const f32x4*)(src + row * 1024 + i * 256 + lane * 4));
            }
#pragma unroll
            for (int q = 0; q < 4; ++q) {
#pragma unroll
                for (int i = 0; i < 4; ++i) ss[q] += xv[q][i].x * xv[q][i].x + xv[q][i].y * xv[q][i].y + xv[q][i].z * xv[q][i].z + xv[q][i].w * xv[q][i].w;
#pragma unroll
                for (int o = 32; o >= 1; o >>= 1) ss[q] += __shfl_xor(ss[q], o);
            }
#pragma unroll
            for (int q = 0; q < 4; ++q) {
                const size_t row = (size_t)vb * 128 + w + 8 * (4 * rr + q);
                const float rstd = rsqrtf(ss[q] * (1.f / 1024.f) + EPS);
#pragma unroll
                for (int i = 0; i < 4; ++i) {
                    const f32x4 y = xv[q][i] * rstd * gs[i] + sh[i];
                    u32x2 o; o.x = pk2(y.x, y.y); o.y = pk2(y.z, y.w);
                    *(u32x2*)(dst + row * 1024 + i * 256 + lane * 4) = o;
                }
            }
        }
    }
}

__device__ __forceinline__ void phase_norm_b(const P& p, const bf16_t* src, const float* g, int sh_off, int sc_off, bf16_t* dst) {
    const int t_ = otid(), lane = t_ & 63, w = t_ >> 6;
    for (int vb = blockIdx.x; vb < 256; vb += gridDim.x) {
        const int b = vb >> 5;
        const float* md = p.mod + (size_t)b * 6144;
        f32x4 gs[4], sh[4];
#pragma unroll
        for (int i = 0; i < 4; ++i) {
            const int e = i * 256 + lane * 4;
            const f32x4 gg = *(const f32x4*)(g + e), sc = *(const f32x4*)(md + sc_off + e);
            gs[i] = gg * (sc + 1.f); sh[i] = *(const f32x4*)(md + sh_off + e);
        }
        for (int rr = 0; rr < 4; ++rr) {
            f32x4 xv[4][4]; float ss[4];
#pragma unroll
            for (int q = 0; q < 4; ++q) {
                const size_t row = (size_t)vb * 128 + w + 8 * (4 * rr + q);
                ss[q] = 0.f;
#pragma unroll
                for (int i = 0; i < 4; ++i) {
                    const u32x2 r = __builtin_nontemporal_load((const u32x2*)(src + row * 1024 + i * 256 + lane * 4));
                    xv[q][i] = (f32x4){__uint_as_float(r.x << 16), __uint_as_float(r.x & 0xFFFF0000u), __uint_as_float(r.y << 16), __uint_as_float(r.y & 0xFFFF0000u)};
                }
            }
#pragma unroll
            for (int q = 0; q < 4; ++q) {
#pragma unroll
                for (int i = 0; i < 4; ++i) ss[q] += xv[q][i].x * xv[q][i].x + xv[q][i].y * xv[q][i].y + xv[q][i].z * xv[q][i].z + xv[q][i].w * xv[q][i].w;
#pragma unroll
                for (int o = 32; o >= 1; o >>= 1) ss[q] += __shfl_xor(ss[q], o);
            }
#pragma unroll
            for (int q = 0; q < 4; ++q) {
                const size_t row = (size_t)vb * 128 + w + 8 * (4 * rr + q);
                const float rstd = rsqrtf(ss[q] * (1.f / 1024.f) + EPS);
#pragma unroll
                for (int i = 0; i < 4; ++i) {
                    const f32x4 y = xv[q][i] * rstd * gs[i] + sh[i];
                    u32x2 o; o.x = pk2(y.x, y.y); o.y = pk2(y.z, y.w);
                    *(u32x2*)(dst + row * 1024 + i * 256 + lane * 4) = o;
                }
            }
        }
    }
}

__device__ __forceinline__ void phase_scan(const P& p) {
    const int t_ = otid();
    for (int task = blockIdx.x * 512 + t_; task < 32 * 4096; task += gridDim.x * 512) {
        const int bh = task >> 12, within = task & 4095, e = within >> 4, d8 = (within & 15) * 8;
        float st[8];
#pragma unroll
        for (int i = 0; i < 8; ++i) st[i] = 0.f;
        for (int n = 0; n < 64; ++n) {
            const size_t ci = (size_t)bh * 64 + n;
            bf16_t* ptr = p.delta + (ci * 256 + e) * 128 + d8;
            const u32x4 dv = *(const u32x4*)ptr;
            const f32x4 d0 = *(const f32x4*)(p.decay + ci * 128 + d8), d1 = *(const f32x4*)(p.decay + ci * 128 + d8 + 4);
            const float dec[8] = {d0.x, d0.y, d0.z, d0.w, d1.x, d1.y, d1.z, d1.w};
            const unsigned w[4] = {dv.x, dv.y, dv.z, dv.w};
            u32x4 o; o.x = pk2(st[0], st[1]); o.y = pk2(st[2], st[3]); o.z = pk2(st[4], st[5]); o.w = pk2(st[6], st[7]);
            *(u32x4*)ptr = o;
#pragma unroll
            for (int i = 0; i < 4; ++i) {
                st[2 * i] = dec[2 * i] * st[2 * i] + __uint_as_float(w[i] << 16);
                st[2 * i + 1] = dec[2 * i + 1] * st[2 * i + 1] + __uint_as_float(w[i] & 0xFFFF0000u);
            }
        }
    }
}

__device__ __forceinline__ void phase_conv(const P& p, int half) {
    const int t_ = otid();
    for (int blk = blockIdx.x; blk < 512; blk += gridDim.x) {
        for (int task = t_; task < 1408; task += 512) {
            const int run = task / 352, cgp = task % 352;
            const int t0 = blk * 64 + run * 16;
            const int chl = cgp * 4, ch = half * 1408 + chl;
            float wa[3][4], wb[3][4], ba[4], bb[4];
#pragma unroll
            for (int j = 0; j < 3; ++j)
#pragma unroll
                for (int i = 0; i < 4; ++i) { wa[j][i] = p.conv_w[j * 5632 + ch + i]; wb[j][i] = p.conv_w[j * 5632 + 2816 + ch + i]; }
#pragma unroll
            for (int i = 0; i < 4; ++i) { ba[i] = p.conv_b[ch + i]; bb[i] = p.conv_b[2816 + ch + i]; }
            float a2[4], a1[4], b2[4], b1[4];
#pragma unroll
            for (int i = 0; i < 4; ++i) { a2[i] = a1[i] = b2[i] = b1[i] = 0.f; }
            if ((t0 & 4095) != 0) {
                const u32x4 r2 = *(const u32x4*)(p.uh + (size_t)(t0 - 2) * 2816 + 2 * chl), r1 = *(const u32x4*)(p.uh + (size_t)(t0 - 1) * 2816 + 2 * chl);
                const unsigned w2[4] = {r2.x, r2.y, r2.z, r2.w}, w1[4] = {r1.x, r1.y, r1.z, r1.w};
#pragma unroll
                for (int i = 0; i < 4; ++i) { a2[i] = __uint_as_float(w2[i] << 16); b2[i] = __uint_as_float(w2[i] & 0xFFFF0000u); a1[i] = __uint_as_float(w1[i] << 16); b1[i] = __uint_as_float(w1[i] & 0xFFFF0000u); }
            }
#pragma unroll
            for (int tt = 0; tt < 16; ++tt) {
                const u32x4 r0 = *(const u32x4*)(p.uh + (size_t)(t0 + tt) * 2816 + 2 * chl);
                const unsigned w0[4] = {r0.x, r0.y, r0.z, r0.w};
                float o[4];
#pragma unroll
                for (int i = 0; i < 4; ++i) {
                    const float a0 = __uint_as_float(w0[i] << 16), b0 = __uint_as_float(w0[i] & 0xFFFF0000u);
                    const float ca = wa[0][i] * a2[i] + wa[1][i] * a1[i] + wa[2][i] * a0 + ba[i];
                    const float cb = wb[0][i] * b2[i] + wb[1][i] * b1[i] + wb[2][i] * b0 + bb[i];
                    o[i] = siluf(ca) * cb;
                    a2[i] = a1[i]; a1[i] = a0; b2[i] = b1[i]; b1[i] = b0;
                }
                u32x2 ov; ov.x = pk2(o[0], o[1]); ov.y = pk2(o[2], o[3]);
                *(u32x2*)(p.act + (size_t)(t0 + tt) * 2816 + ch) = ov;
            }
        }
    }
}

__device__ __forceinline__ void simple_bcum(const P& p, int t, int hh, size_t tok0, float* bc, float* ac, float* wup) {
    for (int i = t; i < 1024; i += 512) ac[i] = p.acode[tok0 * 16 + i];
    for (int i = t; i < 2048; i += 512) wup[i] = p.w_alpha_up[(i >> 7) * 512 + hh * 128 + (i & 127)];
    __syncthreads();
    {
        const int d = t & 127, qt = t >> 7; const float ba = p.b_alpha[hh * 128 + d];
        for (int c = qt * 16; c < qt * 16 + 16; ++c) {
            float z = ba;
#pragma unroll
            for (int r = 0; r < 16; ++r) z += ac[c * 16 + r] * wup[r * 128 + d];
            bc[c * 129 + d] = logsigf(z) * (1.f / 16.f);
        }
    }
    __syncthreads();
    if (t < 128) { float run = 0.f; for (int c = 0; c < 64; ++c) { run += bc[c * 129 + t]; bc[c * 129 + t] = run; } }
    __syncthreads();
}
__device__ __forceinline__ void simple_g1(const P& p, float* sm) {
    float* kk = sm; float* bc = kk + 64 * 129; float* ac = bc + 64 * 129; float* wup = ac + 1024;
    const int t = otid();
    for (int ci = blockIdx.x; ci < 2048; ci += gridDim.x) {
        const int bh = ci >> 6, n = ci & 63, b = bh >> 2, hh = bh & 3;
        const size_t tok0 = (size_t)b * 4096 + n * 64;
        __syncthreads();
        for (int i = t; i < 8192; i += 512) { const int c = i >> 7, d = i & 127; kk[c * 129 + d] = bf2f(p.gk[(tok0 + c) * 512 + hh * 128 + d]); }
        simple_bcum(p, t, hh, tok0, bc, ac, wup);
        for (int i = t; i < 8192; i += 512) { const int c = i >> 7, d = i & 127; kk[c * 129 + d] *= __expf(bc[63 * 129 + d] - bc[c * 129 + d]); }
        if (t < 128) p.decay[(size_t)ci * 128 + t] = __expf(bc[63 * 129 + t]);
        __syncthreads();
        const int d = t & 127;
        for (int e = t >> 7; e < 256; e += 4) {
            const bf16_t* vr = p.gvT + (size_t)(hh * 256 + e) * T + tok0;
            float s = 0.f;
            for (int c = 0; c < 64; ++c) s += bf2f(vr[c]) * kk[c * 129 + d];
            p.delta[((size_t)ci * 256 + e) * 128 + d] = f2bf(s);
        }
    }
}
__device__ __forceinline__ void simple_g3(const P& p, float* sm) {
    float* qq = sm; float* kk = qq + 64 * 129; float* bc = kk + 64 * 129; float* sc = bc + 64 * 129; float* ac = sc + 64 * 65; float* wup = ac + 1024; float* ssum = wup + 2048;
    const int t = otid();
    for (int ci = blockIdx.x; ci < 2048; ci += gridDim.x) {
        const int bh = ci >> 6, n = ci & 63, b = bh >> 2, hh = bh & 3;
        const size_t tok0 = (size_t)b * 4096 + n * 64;
        __syncthreads();
        for (int i = t; i < 8192; i += 512) {
            const int c = i >> 7, d = i & 127;
            qq[c * 129 + d] = bf2f(p.gq[(tok0 + c) * 512 + hh * 128 + d]); kk[c * 129 + d] = bf2f(p.gk[(tok0 + c) * 512 + hh * 128 + d]);
        }
        if (t < 64) ssum[t] = 0.f;
        simple_bcum(p, t, hh, tok0, bc, ac, wup);
        const float scale = 0.08838834764831845f;
        for (int i = t; i < 4096; i += 512) {
            const int c = i >> 6, s = i & 63; float a = 0.f;
            for (int d = 0; d < 128; ++d) a += qq[c * 129 + d] * kk[s * 129 + d] * __expf(-fabsf(bc[c * 129 + d] - bc[s * 129 + d]));
            sc[c * 65 + s] = a * scale;
        }
        __syncthreads();
        for (int i = t; i < 8192; i += 512) { const int c = i >> 7, d = i & 127; qq[c * 129 + d] *= scale * __expf(bc[c * 129 + d]); }
        __syncthreads();
        float* o = kk;
        {
            const int e = t & 255, ch = t >> 8;
            const bf16_t* vr = p.gvT + (size_t)(hh * 256 + e) * T + tok0;
            const bf16_t* sr = p.delta + ((size_t)ci * 256 + e) * 128;
            for (int c = ch * 32; c < ch * 32 + 32; ++c) {
                float a = 0.f;
                for (int s = 0; s < 64; ++s) a += sc[c * 65 + s] * bf2f(vr[s]);
                for (int d = 0; d < 128; ++d) a += qq[c * 129 + d] * bf2f(sr[d]);
                o[c * 256 + e] = a; atomicAdd(&ssum[c], a * a);
            }
        }
        __syncthreads();
        for (int i = t; i < 16384; i += 512) {
            const int c = i >> 8, e = i & 255;
            bf16_t* gp = p.gg + (tok0 + c) * 1024 + hh * 256 + e;
            *gp = f2bf(o[i] * rsqrtf(ssum[c] * (1.f / 256.f) + EPS) * p.gla_norm_g[e] * bf2f(*gp));
        }
    }
}

__device__ __forceinline__ float lambda_full(const P& p) {
    float s1 = 0.f, s2 = 0.f;
    for (int i = 0; i < 64; ++i) { s1 += p.lam_q1[i] * p.lam_k1[i]; s2 += p.lam_q2[i] * p.lam_k2[i]; }
    return __expf(s1) - __expf(s2) + 0.2f;
}
__device__ __forceinline__ void simple_attn(const P& p, float* sm) {
    float* qs = sm; float* ks = qs + 2 * 64 * 65; float* vs = ks + 2 * 64 * 65;
    const int t = otid(), r = t & 63, part = t >> 6, j = part & 1, eq = part >> 1;
    const float lam = lambda_full(p);
    for (int item = blockIdx.x; item < 4096; item += gridDim.x) {
        const int c = 63 - (item >> 6), bh = item & 63, b = bh >> 3, hh = bh & 7;
        const size_t tok0 = (size_t)b * 4096 + c * 64;
        __syncthreads();
        for (int i = t; i < 8192; i += 512) { const int jj = i >> 12, rr = (i >> 6) & 63, d = i & 63; qs[(jj * 64 + rr) * 65 + d] = bf2f(p.dq[(tok0 + rr) * 1024 + hh * 128 + jj * 64 + d]); }
        const float sl2 = exp2f(-(float)(hh + 1)) * LOG2E;
        float m = -INFINITY, l = 0.f, acc[32];
#pragma unroll
        for (int e = 0; e < 32; ++e) acc[e] = 0.f;
        const int qpos = c * 64 + r;
        for (int kt = 0; kt <= c; ++kt) {
            __syncthreads();
            for (int i = t; i < 8192; i += 512) { const int jj = i >> 12, ss = (i >> 6) & 63, d = i & 63; ks[(jj * 64 + ss) * 65 + d] = bf2f(p.dk[((size_t)b * 4096 + kt * 64 + ss) * 1024 + hh * 128 + jj * 64 + d]); }
            for (int i = t; i < 8192; i += 512) { const int ss = i & 63, e = i >> 6; vs[ss * 128 + e] = bf2f(p.dvT[(size_t)(hh * 128 + e) * T + (size_t)b * 4096 + kt * 64 + ss]); }
            __syncthreads();
            for (int s = 0; s < 64; ++s) {
                float dot = 0.f;
#pragma unroll
                for (int d = 0; d < 64; ++d) dot += qs[(j * 64 + r) * 65 + d] * ks[(j * 64 + s) * 65 + d];
                const int kpos = kt * 64 + s;
                const float lg = dot - sl2 * fabsf((float)(qpos - kpos));
                if (lg > m) {
                    const float a = exp2f(m - lg); l *= a;
#pragma unroll
                    for (int e = 0; e < 32; ++e) acc[e] *= a;
                    m = lg;
                }
                const float pp = exp2f(lg - m); l += pp;
#pragma unroll
                for (int e = 0; e < 32; ++e) acc[e] += pp * vs[s * 128 + eq * 32 + e];
            }
        }
        __syncthreads();
        float* buf = ks; float* ssum = qs;
        const float inv = 1.f / l;
        if (j == 1) {
#pragma unroll
            for (int e = 0; e < 32; ++e) buf[r * 128 + eq * 32 + e] = lam * acc[e] * inv;
        }
        if (t < 64) ssum[t] = 0.f;
        __syncthreads();
        if (j == 0) {
            float ss = 0.f;
#pragma unroll
            for (int e = 0; e < 32; ++e) { acc[e] = acc[e] * inv - buf[r * 128 + eq * 32 + e]; ss += acc[e] * acc[e]; }
            atomicAdd(&ssum[r], ss);
        }
        __syncthreads();
        if (j == 0) {
            const float rstd = rsqrtf(ssum[r] * (1.f / 128.f) + EPS) * 0.8f;
            bf16_t* dst = p.dq + (tok0 + r) * 1024 + hh * 128 + eq * 32;
#pragma unroll
            for (int e = 0; e < 32; ++e) dst[e] = f2bf(acc[e] * rstd * p.diff_norm_g[eq * 32 + e]);
        }
    }
}

typedef short bf16x8 __attribute__((ext_vector_type(8)));
typedef float f32x16 __attribute__((ext_vector_type(16)));
__device__ __forceinline__ unsigned cvtpk(float lo, float hi) { return pk2(lo, hi); }
__device__ __forceinline__ void attn_phase(const P& p, char* smem) {
    constexpr int KBYTES = 64 * 272, VBYTES = 128 * 144, TBYTES = KBYTES + VBYTES;
    const int t = otid(), lane = t & 63, w = t >> 6, j = w & 1, g = w >> 1, lq = lane & 31, h = lane >> 5;
    const float lam = lambda_full(p);
    float gqm = 0.f, gkm = 0.f;
    for (int i = 0; i < 64; ++i) { gqm = fmaxf(gqm, fabsf(p.q_norm_g[i])); gkm = fmaxf(gkm, fabsf(p.k_norm_g[i])); }
    const float thr = 2.f * (64.f * 0.125f * LOG2E * gqm * gkm * 1.03f) + 152.f;
    int* qslot = (int*)(smem + 2 * TBYTES);
    if (t == 0) qslot[0] = (int)atomicAdd(p.ctr, 1u);
    __syncthreads();
    int idx = qslot[0], par = 0;
    while (idx < 2048) {
        int nxt_item = 0;
        if (t == 0) nxt_item = (int)atomicAdd(p.ctr, 1u);
        const int qb = 31 - (idx >> 6), bh = idx & 63, b = bh >> 3, hh = bh & 7;
        const int q0 = qb * 128;
        const size_t tokq = (size_t)b * 4096 + q0 + 32 * g + lq;
        bf16x8 qf[4];
#pragma unroll
        for (int ks = 0; ks < 4; ++ks) qf[ks] = *(const bf16x8*)(p.dq + tokq * 1024 + hh * 128 + j * 64 + ks * 16 + h * 8);
        const int cw = 2 * qb + (g >> 1), ktmax = 2 * qb + 1;
        const float sl2 = exp2f(-(float)(hh + 1)) * LOG2E;
        const int xk = q0 - 63 - (int)ceilf(thr / sl2);
        const int ktmin = xk <= 0 ? 0 : (xk + 63) >> 6;
        f32x16 cinit;
#pragma unroll
        for (int r = 0; r < 16; ++r) cinit[r] = sl2 * (float)((r & 3) + 8 * (r >> 2));
        f32x16 O[4];
#pragma unroll
        for (int eb = 0; eb < 4; ++eb)
#pragma unroll
            for (int r = 0; r < 16; ++r) O[eb][r] = 0.f;
        float m = -INFINITY, l = 0.f;
        const bf16_t* kbase = p.dk + (size_t)b * 4096 * 1024 + hh * 128; const bf16_t* vbase = p.dvT + (size_t)hh * 128 * T + (size_t)b * 4096;
        int ksrc[2], vsrc[2], kdst[2], vdst[2];
#pragma unroll
        for (int i = 0; i < 2; ++i) {
            const int ck = t + 512 * i;
            { const int row = ck >> 4, cc = ck & 15; ksrc[i] = row * 1024 + cc * 8; kdst[i] = row * 272 + cc * 16; }
            { const int e = ck >> 3, cc = ck & 7; vsrc[i] = e * T + cc * 8; vdst[i] = KBYTES + e * 144 + (cc >> 1) * 32 + (cc & 1) * 8; }
        }
        {
            u32x4 kr[2], vr[2];
#pragma unroll
            for (int i = 0; i < 2; ++i) { kr[i] = *(const u32x4*)(kbase + (size_t)ktmax * 64 * 1024 + ksrc[i]); vr[i] = *(const u32x4*)(vbase + ktmax * 64 + vsrc[i]); }
#pragma unroll
            for (int i = 0; i < 2; ++i) {
                *(u32x4*)(smem + kdst[i]) = kr[i];
                *(u32x2*)(smem + vdst[i]) = (u32x2){vr[i].x, vr[i].y}; *(u32x2*)(smem + vdst[i] + 16) = (u32x2){vr[i].z, vr[i].w};
            }
        }
        __syncthreads();
        int cur = 0;
        for (int kt = ktmax; kt >= ktmin; --kt) {
            u32x4 kr[2], vr[2];
            if (kt > ktmin) {
#pragma unroll
                for (int i = 0; i < 2; ++i) { kr[i] = *(const u32x4*)(kbase + (size_t)(kt - 1) * 64 * 1024 + ksrc[i]); vr[i] = *(const u32x4*)(vbase + (kt - 1) * 64 + vsrc[i]); }
            }
            if (kt <= cw) {
                const char* Kb = smem + cur * TBYTES; const char* Vb = Kb + KBYTES;
                f32x16 S[2];
#pragma unroll
                for (int kb = 0; kb < 2; ++kb) {
                    S[kb] = cinit;
#pragma unroll
                    for (int ks = 0; ks < 4; ++ks) {
                        const bf16x8 a = *(const bf16x8*)(Kb + (kb * 32 + lq) * 272 + j * 128 + ks * 32 + h * 16);
                        S[kb] = __builtin_amdgcn_mfma_f32_32x32x16_bf16(a, qf[ks], S[kb], 0, 0, 0);
                    }
                }
                if (kt == cw) {
                    int qi = 32 * (g & 1) + lq; asm volatile("" : "+v"(qi));
#pragma unroll
                    for (int kb = 0; kb < 2; ++kb)
#pragma unroll
                        for (int r = 0; r < 16; ++r) {
                            const int keyi = kb * 32 + (r & 3) + 8 * (r >> 2) + 4 * h;
                            S[kb][r] += 2.f * sl2 * fminf((float)(qi - keyi), 0.f);
                        }
                }
                const float base0 = sl2 * (float)(kt * 64 + 4 * h - q0), base1 = base0 + sl2 * 32.f;
                float mx0 = S[0][0], mx1 = S[1][0];
#pragma unroll
                for (int r = 1; r < 16; ++r) { mx0 = fmaxf(mx0, S[0][r]); mx1 = fmaxf(mx1, S[1][r]); }
                float mloc = fmaxf(mx0 + base0, mx1 + base1);
                mloc = fmaxf(mloc, __shfl_xor(mloc, 32));
                const float mnew = fmaxf(m, mloc);
                if (__any(mnew > m)) {
                    const float alpha = __builtin_amdgcn_exp2f(m - mnew);
                    l *= alpha;
#pragma unroll
                    for (int eb = 0; eb < 4; ++eb)
#pragma unroll
                        for (int r = 0; r < 16; ++r) O[eb][r] *= alpha;
                }
                m = mnew;
                const float off0 = base0 - m, off1 = base1 - m;
                float ls = 0.f;
#pragma unroll
                for (int r = 0; r < 16; ++r) { S[0][r] = __builtin_amdgcn_exp2f(S[0][r] + off0); S[1][r] = __builtin_amdgcn_exp2f(S[1][r] + off1); ls += S[0][r] + S[1][r]; }
                l += ls;
                bf16x8 pf[4];
#pragma unroll
                for (int kk = 0; kk < 4; ++kk) {
                    const int kb = kk >> 1, s8 = (kk & 1) * 8;
                    u32x4 pk; pk.x = cvtpk(S[kb][s8 + 0], S[kb][s8 + 1]); pk.y = cvtpk(S[kb][s8 + 2], S[kb][s8 + 3]); pk.z = cvtpk(S[kb][s8 + 4], S[kb][s8 + 5]); pk.w = cvtpk(S[kb][s8 + 6], S[kb][s8 + 7]);
                    pf[kk] = __builtin_bit_cast(bf16x8, pk);
                }
#pragma unroll
                for (int eb = 0; eb < 4; ++eb)
#pragma unroll
                    for (int kk = 0; kk < 4; ++kk) {
                        const bf16x8 a = *(const bf16x8*)(Vb + (eb * 32 + lq) * 144 + kk * 32 + h * 16);
                        O[eb] = __builtin_amdgcn_mfma_f32_32x32x16_bf16(a, pf[kk], O[eb], 0, 0, 0);
                    }
            }
            if (kt > ktmin) {
                char* nb = smem + (cur ^ 1) * TBYTES;
#pragma unroll
                for (int i = 0; i < 2; ++i) {
                    *(u32x4*)(nb + kdst[i]) = kr[i];
                    *(u32x2*)(nb + vdst[i]) = (u32x2){vr[i].x, vr[i].y}; *(u32x2*)(nb + vdst[i] + 16) = (u32x2){vr[i].z, vr[i].w};
                }
            }
            __syncthreads();
            cur ^= 1;
        }
        l += __shfl_xor(l, 32);
        const float inv = 1.f / l;
        float* ob = (float*)smem;
        if (j == 1) {
            const float sc = lam * inv;
#pragma unroll
            for (int eb = 0; eb < 4; ++eb)
#pragma unroll
                for (int r = 0; r < 16; ++r) { const int e = eb * 32 + (r & 3) + 8 * (r >> 2) + 4 * h; ob[(g * 128 + e) * 32 + lq] = O[eb][r] * sc; }
        }
        __syncthreads();
        if (j == 0) {
            float ss = 0.f;
#pragma unroll
            for (int eb = 0; eb < 4; ++eb)
#pragma unroll
                for (int r = 0; r < 16; ++r) { const int e = eb * 32 + (r & 3) + 8 * (r >> 2) + 4 * h; const float o = O[eb][r] * inv - ob[(g * 128 + e) * 32 + lq]; O[eb][r] = o; ss += o * o; }
            ss += __shfl_xor(ss, 32);
            const float rstd = rsqrtf(ss * (1.f / 128.f) + EPS) * 0.8f;
            bf16_t* dst = p.h + tokq * 1024 + hh * 128;
#pragma unroll
            for (int eb = 0; eb < 4; ++eb)
#pragma unroll
                for (int i = 0; i < 4; ++i) {
                    const int e0 = eb * 32 + 8 * i + 4 * h;
                    const f32x4 gv = *(const f32x4*)(p.diff_norm_g + e0);
                    u32x2 o; o.x = pk2(O[eb][4 * i] * rstd * gv.x, O[eb][4 * i + 1] * rstd * gv.y); o.y = pk2(O[eb][4 * i + 2] * rstd * gv.z, O[eb][4 * i + 3] * rstd * gv.w);
                    *(u32x2*)(dst + e0) = o;
                }
        }
        if (t == 0) qslot[par ^ 1] = nxt_item;
        __syncthreads();
        idx = qslot[par ^ 1]; par ^= 1;
    }
}

template <int CTRL, int ROWMASK> __device__ __forceinline__ float dpp_add(float x) {
    return x + __builtin_bit_cast(float, __builtin_amdgcn_update_dpp(0, __builtin_bit_cast(int, x), CTRL, ROWMASK, 0xf, false));
}
__device__ __forceinline__ float wave_incl_scan(float x) {
    x = dpp_add<0x111, 0xf>(x); x = dpp_add<0x112, 0xf>(x); x = dpp_add<0x114, 0xf>(x); x = dpp_add<0x118, 0xf>(x);
    x = dpp_add<0x142, 0xa>(x); x = dpp_add<0x143, 0xc>(x);
    return x;
}
__device__ __forceinline__ void gla_load_ac(const P& p, size_t tok0, int lane, float (&ac)[16]) {
#pragma unroll
    for (int i = 0; i < 4; ++i) { const f32x4 v = *(const f32x4*)(p.acode + (tok0 + lane) * 16 + 4 * i); ac[4 * i] = v.x; ac[4 * i + 1] = v.y; ac[4 * i + 2] = v.z; ac[4 * i + 3] = v.w; }
}
__device__ __forceinline__ void gla_gate4(const float* wl, int d0, int lane, const float (&ac)[16], float (&B4)[4]) {
    f32x4 z = *(const f32x4*)(wl + 8192 + d0);
#pragma unroll
    for (int r = 0; r < 16; ++r) { const f32x4 wv = *(const f32x4*)(wl + r * 512 + d0); z.x += ac[r] * wv.x; z.y += ac[r] * wv.y; z.z += ac[r] * wv.z; z.w += ac[r] * wv.w; }
    const float zz[4] = {z.x, z.y, z.z, z.w};
#pragma unroll
    for (int i = 0; i < 4; ++i) B4[i] = wave_incl_scan(logsigf(zz[i]) * (1.f / 16.f));
}
__device__ __forceinline__ void gla_stage_w(const P& p, float* wl, int t) {
    for (int i = t; i < 8192; i += 512) wl[i] = p.w_alpha_up[i];
    wl[8192 + t] = p.b_alpha[t];
}
__device__ __forceinline__ void ldbf16x16(const bf16_t* src, float (&v)[16]) { ld16_bf16(src, v); }
__device__ __forceinline__ void g1_phase(const P& p, char* smem) {
    char* KD = smem;
    const int t = otid(), lane = t & 63, w = __builtin_amdgcn_readfirstlane(t >> 6), lq = lane & 31, h = lane >> 5;
    float* wl = (float*)(smem + 20480); gla_stage_w(p, wl, t);
    for (int ci = blockIdx.x; ci < 2048; ci += gridDim.x) {
        const int bh = ci >> 6, n = ci & 63, b = bh >> 2, hh = bh & 3;
        const size_t tok0 = (size_t)b * 4096 + n * 64;
        __syncthreads();
        bf16x8 bV[4];
#pragma unroll
        for (int ks = 0; ks < 4; ++ks) bV[ks] = *(const bf16x8*)(p.gvT + (tok0 >> 6) * 65536 + (size_t)(hh * 256 + 32 * w + lq) * 64 + ks * 16 + h * 8);
        {
            float ac[16]; gla_load_ac(p, tok0, lane, ac);
            const bf16_t* kp = p.gk + (tok0 + lane) * 512 + hh * 128 + 16 * w;
            const u32x4 kA = *(const u32x4*)kp, kB = *(const u32x4*)(kp + 8);
#pragma unroll 1
            for (int grp = 0; grp < 4; ++grp) {
                const int dl = 16 * w + 4 * grp;
                u32x2 kr; kr.x = grp == 0 ? kA.x : grp == 1 ? kA.z : grp == 2 ? kB.x : kB.z; kr.y = grp == 0 ? kA.y : grp == 1 ? kA.w : grp == 2 ? kB.y : kB.w;
                float B4[4]; gla_gate4(wl, hh * 128 + dl, lane, ac, B4);
                const float kv[4] = {__uint_as_float(kr.x << 16), __uint_as_float(kr.x & 0xFFFF0000u), __uint_as_float(kr.y << 16), __uint_as_float(kr.y & 0xFFFF0000u)};
#pragma unroll
                for (int i = 0; i < 4; ++i) {
                    const float Bl = __shfl(B4[i], 63);
                    *(bf16_t*)(KD + (dl + i) * 144 + lane * 2) = f2bf(kv[i] * __expf(Bl - B4[i]));
                    if (lane == 63) p.decay[(size_t)ci * 128 + dl + i] = __expf(B4[i]);
                }
            }
        }
        __syncthreads();
        bf16_t* drow = p.delta + ((size_t)ci * 256 + 32 * w + lq) * 128;
#pragma unroll
        for (int db = 0; db < 4; ++db) {
            f32x16 acc;
#pragma unroll
            for (int r = 0; r < 16; ++r) acc[r] = 0.f;
#pragma unroll
            for (int ks = 0; ks < 4; ++ks) {
                const bf16x8 a = *(const bf16x8*)(KD + (db * 32 + lq) * 144 + ks * 32 + h * 16);
                acc = __builtin_amdgcn_mfma_f32_32x32x16_bf16(a, bV[ks], acc, 0, 0, 0);
            }
#pragma unroll
            for (int i = 0; i < 4; ++i) {
                u32x2 o; o.x = pk2(acc[4 * i], acc[4 * i + 1]); o.y = pk2(acc[4 * i + 2], acc[4 * i + 3]);
                *(u32x2*)(drow + db * 32 + 8 * i + 4 * h) = o;
            }
        }
    }
}
__device__ __forceinline__ void g3_phase(const P& p, char* smem) {
    constexpr int AB = 64 * 272;
    char* QF = smem; char* KF = smem + AB; char* QB = smem + 2 * AB; char* KBW = smem + 3 * AB; char* SC = smem + 4 * AB; float* ssum = (float*)(smem + 4 * AB + 64 * 144);
    const int t = otid(), lane = t & 63, w = __builtin_amdgcn_readfirstlane(t >> 6), lq = lane & 31, h = lane >> 5;
    const float scale = 0.08838834764831845f;
    float* wl = (float*)(smem + 81920); gla_stage_w(p, wl, t);
    for (int ci = blockIdx.x; ci < 2048; ci += gridDim.x) {
        const int bh = ci >> 6, n = ci & 63, b = bh >> 2, hh = bh & 3;
        const size_t tok0 = (size_t)b * 4096 + n * 64;
        __syncthreads();
        if (t < 64) ssum[t] = 0.f;
        bf16x8 aV[4], aS[8];
#pragma unroll
        for (int ks = 0; ks < 4; ++ks) aV[ks] = *(const bf16x8*)(p.gvT + (tok0 >> 6) * 65536 + (size_t)(hh * 256 + 32 * w + lq) * 64 + ks * 16 + h * 8);
#pragma unroll
        for (int ks = 0; ks < 8; ++ks) aS[ks] = *(const bf16x8*)(p.delta + ((size_t)ci * 256 + 32 * w + lq) * 128 + ks * 16 + h * 8);
        {
            float ac[16]; gla_load_ac(p, tok0, lane, ac);
            const bf16_t* qp = p.gq + (tok0 + lane) * 512 + hh * 128 + 16 * w; const bf16_t* kp = p.gk + (tok0 + lane) * 512 + hh * 128 + 16 * w;
            const u32x4 qA = *(const u32x4*)qp, qB = *(const u32x4*)(qp + 8), kA = *(const u32x4*)kp, kB = *(const u32x4*)(kp + 8);
#pragma unroll 1
            for (int grp = 0; grp < 4; ++grp) {
                const int dl = 16 * w + 4 * grp;
                u32x2 qr, kr;
                qr.x = grp == 0 ? qA.x : grp == 1 ? qA.z : grp == 2 ? qB.x : qB.z; qr.y = grp == 0 ? qA.y : grp == 1 ? qA.w : grp == 2 ? qB.y : qB.w;
                kr.x = grp == 0 ? kA.x : grp == 1 ? kA.z : grp == 2 ? kB.x : kB.z; kr.y = grp == 0 ? kA.y : grp == 1 ? kA.w : grp == 2 ? kB.y : kB.w;
                float B4[4]; gla_gate4(wl, hh * 128 + dl, lane, ac, B4);
                const float qv[4] = {__uint_as_float(qr.x << 16), __uint_as_float(qr.x & 0xFFFF0000u), __uint_as_float(qr.y << 16), __uint_as_float(qr.y & 0xFFFF0000u)};
                const float kv[4] = {__uint_as_float(kr.x << 16), __uint_as_float(kr.x & 0xFFFF0000u), __uint_as_float(kr.y << 16), __uint_as_float(kr.y & 0xFFFF0000u)};
                float a0[4], a1[4], a2[4], a3[4];
#pragma unroll
                for (int i = 0; i < 4; ++i) {
                    const float eB = __expf(B4[i]), emB = __expf(-B4[i]), qs = qv[i] * scale;
                    a0[i] = qs * eB; a1[i] = kv[i] * emB; a2[i] = qs * emB; a3[i] = kv[i] * eB;
                }
                const int off = lane * 272 + 2 * dl;
                *(u32x2*)(QF + off) = (u32x2){pk2(a0[0], a0[1]), pk2(a0[2], a0[3])}; *(u32x2*)(KF + off) = (u32x2){pk2(a1[0], a1[1]), pk2(a1[2], a1[3])};
                *(u32x2*)(QB + off) = (u32x2){pk2(a2[0], a2[1]), pk2(a2[2], a2[3])}; *(u32x2*)(KBW + off) = (u32x2){pk2(a3[0], a3[1]), pk2(a3[2], a3[3])};
            }
        }
        __syncthreads();
        {
            const int var = w >> 2, sb = w & 1, cb = (w >> 1) & 1;
            const char* Ab = (var ? KBW : KF) + (sb * 32 + lq) * 272 + h * 16; const char* Bb = (var ? QB : QF) + (cb * 32 + lq) * 272 + h * 16;
            f32x16 acc;
#pragma unroll
            for (int r = 0; r < 16; ++r) acc[r] = 0.f;
#pragma unroll
            for (int ks = 0; ks < 8; ++ks) acc = __builtin_amdgcn_mfma_f32_32x32x16_bf16(*(const bf16x8*)(Ab + ks * 32), *(const bf16x8*)(Bb + ks * 32), acc, 0, 0, 0);
            const int c = cb * 32 + lq;
#pragma unroll
            for (int r = 0; r < 16; ++r) {
                const int sidx = sb * 32 + (r & 3) + 8 * (r >> 2) + 4 * h;
                const bool keep = var ? (sidx > c) : (sidx <= c);
                if (keep) *(bf16_t*)(SC + c * 144 + sidx * 2) = f2bf(acc[r]);
            }
        }
        __syncthreads();
        u32x2 ggr[2][4];
#pragma unroll
        for (int cb = 0; cb < 2; ++cb)
#pragma unroll
            for (int i = 0; i < 4; ++i) ggr[cb][i] = *(const u32x2*)(p.gg + (tok0 + cb * 32 + lq) * 1024 + hh * 256 + 32 * w + 8 * i + 4 * h);
        f32x16 o[2];
#pragma unroll
        for (int cb = 0; cb < 2; ++cb) {
#pragma unroll
            for (int r = 0; r < 16; ++r) o[cb][r] = 0.f;
#pragma unroll
            for (int ks = 0; ks < 4; ++ks) o[cb] = __builtin_amdgcn_mfma_f32_32x32x16_bf16(aV[ks], *(const bf16x8*)(SC + (cb * 32 + lq) * 144 + ks * 32 + h * 16), o[cb], 0, 0, 0);
#pragma unroll
            for (int ks = 0; ks < 8; ++ks) o[cb] = __builtin_amdgcn_mfma_f32_32x32x16_bf16(aS[ks], *(const bf16x8*)(QF + (cb * 32 + lq) * 272 + ks * 32 + h * 16), o[cb], 0, 0, 0);
            float ss = 0.f;
#pragma unroll
            for (int r = 0; r < 16; ++r) ss += o[cb][r] * o[cb][r];
            ss += __shfl_xor(ss, 32);
            if (h == 0) atomicAdd(&ssum[cb * 32 + lq], ss);
        }
        __syncthreads();
#pragma unroll
        for (int cb = 0; cb < 2; ++cb) {
            const int c = cb * 32 + lq;
            const float rstd = rsqrtf(ssum[c] * (1.f / 256.f) + EPS);
            bf16_t* gp = p.gg + (tok0 + c) * 1024 + hh * 256;
#pragma unroll
            for (int i = 0; i < 4; ++i) {
                const int e0 = 32 * w + 8 * i + 4 * h;
                const u32x2 gr = ggr[cb][i];
                const f32x4 ng = *(const f32x4*)(p.gla_norm_g + e0);
                u32x2 ov;
                ov.x = pk2(o[cb][4 * i] * rstd * ng.x * __uint_as_float(gr.x << 16), o[cb][4 * i + 1] * rstd * ng.y * __uint_as_float(gr.x & 0xFFFF0000u));
                ov.y = pk2(o[cb][4 * i + 2] * rstd * ng.z * __uint_as_float(gr.y << 16), o[cb][4 * i + 3] * rstd * ng.w * __uint_as_float(gr.y & 0xFFFF0000u));
                *(u32x2*)(gp + e0) = ov;
            }
        }
    }
}

__device__ __forceinline__ void lds_barrier() { asm volatile("s_waitcnt lgkmcnt(0)" ::: "memory"); __builtin_amdgcn_s_barrier(); asm volatile("" ::: "memory"); }
__device__ __forceinline__ const bf16_t* kdt_ptr(const P& p, int bh, int n) { return (n < 24 ? p.kdtA : p.kdtB) + (size_t)(bh * 24 + (n < 24 ? n : n - 24)) * 8192; }
__device__ __forceinline__ void gla_prepass(const P& p, char* smem) {
    char* KD = smem;
    const int t = otid(), lane = t & 63, w = __builtin_amdgcn_readfirstlane(t >> 6);
    float* wl = (float*)(smem + 20480); gla_stage_w(p, wl, t);
    for (int item = blockIdx.x; item < 32 * 48; item += gridDim.x) {
        const int bh = item / 48, n = item % 48, b = bh >> 2, hh = bh & 3;
        const size_t tok0 = (size_t)b * 4096 + n * 64;
        __syncthreads();
        {
            float ac[16]; gla_load_ac(p, tok0, lane, ac);
            const bf16_t* kp = p.gk + (tok0 + lane) * 512 + hh * 128 + 16 * w;
            const u32x4 kA = *(const u32x4*)kp, kB = *(const u32x4*)(kp + 8);
#pragma unroll 1
            for (int grp = 0; grp < 4; ++grp) {
                const int dl = 16 * w + 4 * grp;
                u32x2 kr; kr.x = grp == 0 ? kA.x : grp == 1 ? kA.z : grp == 2 ? kB.x : kB.z; kr.y = grp == 0 ? kA.y : grp == 1 ? kA.w : grp == 2 ? kB.y : kB.w;
                float B4[4]; gla_gate4(wl, hh * 128 + dl, lane, ac, B4);
                const float kv[4] = {__uint_as_float(kr.x << 16), __uint_as_float(kr.x & 0xFFFF0000u), __uint_as_float(kr.y << 16), __uint_as_float(kr.y & 0xFFFF0000u)};
#pragma unroll
                for (int i = 0; i < 4; ++i) {
                    const float Bl = __builtin_bit_cast(float, __builtin_amdgcn_readlane(__builtin_bit_cast(int, B4[i]), 63));
                    *(bf16_t*)(KD + (dl + i) * 144 + lane * 2) = f2bf(kv[i] * __expf(Bl - B4[i]));
                    if (lane == 63) p.decg[(size_t)(bh * 48 + n) * 128 + dl + i] = __expf(B4[i]);
                }
            }
        }
        __syncthreads();
        {
            const int row = t >> 2, sg = t & 3;
            bf16_t* dst = (bf16_t*)kdt_ptr(p, bh, n) + row * 64 + sg * 16;
            const char* src = KD + row * 144 + sg * 32;
            *(u32x4*)dst = *(const u32x4*)src; *(u32x4*)(dst + 8) = *(const u32x4*)(src + 16);
        }
    }
}

__device__ __forceinline__ void gla_seq(const P& p, char* smem, int bh, int part) {
    constexpr int NPART = 4, CPP = 64 / NPART;
    constexpr int AB = 64 * 272;
    char* QF = smem; char* KF = smem + AB; char* QB = smem + 2 * AB; char* KBW = smem + 3 * AB; char* SC = smem + 4 * AB;
    char* KD0 = smem + 78848; char* KD1 = smem + 133120;
    float* ssum = (float*)(smem + 97280);
    float* dec0 = (float*)(smem + 97536); float* dec1 = (float*)(smem + 151552);
    float* wl = (float*)(smem + 98304);
    const int t = otid(), lane = t & 63, w = __builtin_amdgcn_readfirstlane(t >> 6), lq = lane & 31, h = lane >> 5;
    const float scale = 0.08838834764831845f;
    gla_stage_w(p, wl, t);
    const int b = bh >> 2, hh = bh & 3;
    f32x16 st[4];
#pragma unroll
    for (int db = 0; db < 4; ++db)
#pragma unroll
        for (int r = 0; r < 16; ++r) st[db][r] = 0.f;
    f32x4 acn[4]; u32x4 kAn, kBn;
#define GLA_LOAD_OPS(TOK) do { const size_t tk_ = (TOK); \
        _Pragma("unroll") for (int i = 0; i < 4; ++i) acn[i] = *(const f32x4*)(p.acode + (tk_ + lane) * 16 + 4 * i); \
        { const bf16_t* kp_ = p.gk + (tk_ + lane) * 512 + hh * 128 + 16 * w; \
          kAn = *(const u32x4*)kp_; kBn = *(const u32x4*)(kp_ + 8); } } while (0)
    const int nend = (part + 1) * CPP;
    for (int n = 0; n < nend; ++n) {
        const bool full = n >= part * CPP;
        const size_t tok0 = (size_t)b * 4096 + n * 64;
        if (!full) {
            const bf16_t* kd = kdt_ptr(p, bh, n); const float* dg = p.decg + (size_t)(bh * 48 + n) * 128;
            bf16x8 vR[4];
#pragma unroll
            for (int ks = 0; ks < 4; ++ks) vR[ks] = *(const bf16x8*)(p.gvT + (tok0 >> 6) * 65536 + (size_t)(hh * 256 + 32 * w + lq) * 64 + ks * 16 + h * 8);
#pragma unroll
            for (int db = 0; db < 4; ++db) {
                bf16x8 ak[4];
#pragma unroll
                for (int ks = 0; ks < 4; ++ks) ak[ks] = *(const bf16x8*)(kd + (db * 32 + lq) * 64 + ks * 16 + h * 8);
#pragma unroll
                for (int i = 0; i < 4; ++i) { const f32x4 dv = *(const f32x4*)(dg + db * 32 + 8 * i + 4 * h); st[db][4 * i] *= dv.x; st[db][4 * i + 1] *= dv.y; st[db][4 * i + 2] *= dv.z; st[db][4 * i + 3] *= dv.w; }
#pragma unroll
                for (int ks = 0; ks < 4; ++ks) st[db] = __builtin_amdgcn_mfma_f32_32x32x16_bf16(ak[ks], vR[ks], st[db], 0, 0, 0);
            }
            continue;
        }
        char* KD = KD0; float* dec = dec0;
        __syncthreads();
        if (t < 64) ssum[t] = 0.f;
        bf16x8 vT[4]; u32x2 ggr[2][4]; float ac[16];
        GLA_LOAD_OPS(tok0);
        const u32x4 kA = kAn, kB = kBn;
        u32x4 qA = {0u, 0u, 0u, 0u}, qB = {0u, 0u, 0u, 0u};
        if (full) { const bf16_t* qp_ = p.gq + (tok0 + lane) * 512 + hh * 128 + 16 * w; qA = *(const u32x4*)qp_; qB = *(const u32x4*)(qp_ + 8); }
#pragma unroll
        for (int i = 0; i < 4; ++i) { ac[4 * i] = acn[i].x; ac[4 * i + 1] = acn[i].y; ac[4 * i + 2] = acn[i].z; ac[4 * i + 3] = acn[i].w; }
#pragma unroll
        for (int ks = 0; ks < 4; ++ks) vT[ks] = *(const bf16x8*)(p.gvT + (tok0 >> 6) * 65536 + (size_t)(hh * 256 + 32 * w + lq) * 64 + ks * 16 + h * 8);
        if (full) {
#pragma unroll
            for (int cb = 0; cb < 2; ++cb)
#pragma unroll
                for (int i = 0; i < 4; ++i) ggr[cb][i] = *(const u32x2*)(p.gg + (tok0 + cb * 32 + lq) * 1024 + hh * 256 + 32 * w + 8 * i + 4 * h);
        }
        {
#pragma unroll 1
            for (int grp = 0; grp < 4; ++grp) {
                const int dl = 16 * w + 4 * grp;
                u32x2 qr, kr;
                qr.x = grp == 0 ? qA.x : grp == 1 ? qA.z : grp == 2 ? qB.x : qB.z; qr.y = grp == 0 ? qA.y : grp == 1 ? qA.w : grp == 2 ? qB.y : qB.w;
                kr.x = grp == 0 ? kA.x : grp == 1 ? kA.z : grp == 2 ? kB.x : kB.z; kr.y = grp == 0 ? kA.y : grp == 1 ? kA.w : grp == 2 ? kB.y : kB.w;
                float B4[4]; gla_gate4(wl, hh * 128 + dl, lane, ac, B4);
                const float qv[4] = {__uint_as_float(qr.x << 16), __uint_as_float(qr.x & 0xFFFF0000u), __uint_as_float(qr.y << 16), __uint_as_float(qr.y & 0xFFFF0000u)};
                const float kv[4] = {__uint_as_float(kr.x << 16), __uint_as_float(kr.x & 0xFFFF0000u), __uint_as_float(kr.y << 16), __uint_as_float(kr.y & 0xFFFF0000u)};
                float a0[4], a1[4], a2[4], a3[4];
#pragma unroll
                for (int i = 0; i < 4; ++i) {
                    const float eB = __expf(B4[i]), emB = __expf(-B4[i]), qs = qv[i] * scale;
                    a0[i] = qs * eB; a1[i] = kv[i] * emB; a2[i] = qs * emB; a3[i] = kv[i] * eB;
                    const float Bl = __builtin_bit_cast(float, __builtin_amdgcn_readlane(__builtin_bit_cast(int, B4[i]), 63));
                    *(bf16_t*)(KD + (dl + i) * 144 + lane * 2) = f2bf(kv[i] * emB * __expf(Bl));
                    if (lane == 63) dec[dl + i] = eB;
                }
                if (full) {
                    const int off = lane * 272 + 2 * dl;
                    *(u32x2*)(QF + off) = (u32x2){pk2(a0[0], a0[1]), pk2(a0[2], a0[3])}; *(u32x2*)(KF + off) = (u32x2){pk2(a1[0], a1[1]), pk2(a1[2], a1[3])};
                    *(u32x2*)(QB + off) = (u32x2){pk2(a2[0], a2[1]), pk2(a2[2], a2[3])}; *(u32x2*)(KBW + off) = (u32x2){pk2(a3[0], a3[1]), pk2(a3[2], a3[3])};
                }
            }
        }
        __syncthreads();
        f32x16 o[2];
        if (full) {
        {
            const int var = w >> 2, sb = w & 1, cb = (w >> 1) & 1;
            const char* Ab = (var ? KBW : KF) + (sb * 32 + lq) * 272 + h * 16; const char* Bb = (var ? QB : QF) + (cb * 32 + lq) * 272 + h * 16;
            f32x16 acc;
#pragma unroll
            for (int r = 0; r < 16; ++r) acc[r] = 0.f;
#pragma unroll
            for (int ks = 0; ks < 8; ++ks) acc = __builtin_amdgcn_mfma_f32_32x32x16_bf16(*(const bf16x8*)(Ab + ks * 32), *(const bf16x8*)(Bb + ks * 32), acc, 0, 0, 0);
            const int c = cb * 32 + lq;
#pragma unroll
            for (int r = 0; r < 16; ++r) {
                const int sidx = sb * 32 + (r & 3) + 8 * (r >> 2) + 4 * h;
                const bool keep = var ? (sidx > c) : (sidx <= c);
                if (keep) *(bf16_t*)(SC + c * 144 + sidx * 2) = f2bf(acc[r]);
            }
        }
        __syncthreads();
#pragma unroll
        for (int cb = 0; cb < 2; ++cb)
#pragma unroll
            for (int r = 0; r < 16; ++r) o[cb][r] = 0.f;
#pragma unroll
        for (int ks = 0; ks < 4; ++ks)
#pragma unroll
            for (int cb = 0; cb < 2; ++cb) o[cb] = __builtin_amdgcn_mfma_f32_32x32x16_bf16(vT[ks], *(const bf16x8*)(SC + (cb * 32 + lq) * 144 + ks * 32 + h * 16), o[cb], 0, 0, 0);
#pragma unroll
        for (int ks = 0; ks < 8; ++ks) {
            const int db = ks >> 1, s8 = (ks & 1) * 8;
            u32x4 pk; pk.x = pk2(st[db][s8 + 0], st[db][s8 + 1]); pk.y = pk2(st[db][s8 + 2], st[db][s8 + 3]); pk.z = pk2(st[db][s8 + 4], st[db][s8 + 5]); pk.w = pk2(st[db][s8 + 6], st[db][s8 + 7]);
            const bf16x8 aS = __builtin_bit_cast(bf16x8, pk);
#pragma unroll
            for (int cb = 0; cb < 2; ++cb) {
                const char* qrow = QF + (cb * 32 + lq) * 272 + ks * 32 + h * 8;
                const u32x2 lo = *(const u32x2*)qrow, hi = *(const u32x2*)(qrow + 16);
                const u32x4 bq = {lo.x, lo.y, hi.x, hi.y};
                o[cb] = __builtin_amdgcn_mfma_f32_32x32x16_bf16(aS, __builtin_bit_cast(bf16x8, bq), o[cb], 0, 0, 0);
            }
        }
#pragma unroll
        for (int cb = 0; cb < 2; ++cb) {
            float ss = 0.f;
#pragma unroll
            for (int r = 0; r < 16; ++r) ss += o[cb][r] * o[cb][r];
            ss += __shfl_xor(ss, 32);
            if (h == 0) atomicAdd(&ssum[cb * 32 + lq], ss);
        }
        }
#pragma unroll
        for (int db = 0; db < 4; ++db) {
#pragma unroll
            for (int i = 0; i < 4; ++i) {
                const f32x4 dv = *(const f32x4*)(dec + db * 32 + 8 * i + 4 * h);
                st[db][4 * i] *= dv.x; st[db][4 * i + 1] *= dv.y; st[db][4 * i + 2] *= dv.z; st[db][4 * i + 3] *= dv.w;
            }
#pragma unroll
            for (int ks = 0; ks < 4; ++ks) st[db] = __builtin_amdgcn_mfma_f32_32x32x16_bf16(*(const bf16x8*)(KD + (db * 32 + lq) * 144 + ks * 32 + h * 16), vT[ks], st[db], 0, 0, 0);
        }
        if (full) {
        __syncthreads();
#pragma unroll
        for (int cb = 0; cb < 2; ++cb) {
            const int c = cb * 32 + lq;
            const float rstd = rsqrtf(ssum[c] * (1.f / 256.f) + EPS);
            bf16_t* gp = p.gg + (tok0 + c) * 1024 + hh * 256;
#pragma unroll
            for (int i = 0; i < 4; ++i) {
                const int e0 = 32 * w + 8 * i + 4 * h;
                const u32x2 gr = ggr[cb][i];
                const f32x4 ng = *(const f32x4*)(p.gla_norm_g + e0);
                u32x2 ov;
                ov.x = pk2(o[cb][4 * i] * rstd * ng.x * __uint_as_float(gr.x << 16), o[cb][4 * i + 1] * rstd * ng.y * __uint_as_float(gr.x & 0xFFFF0000u));
                ov.y = pk2(o[cb][4 * i + 2] * rstd * ng.z * __uint_as_float(gr.y << 16), o[cb][4 * i + 3] * rstd * ng.w * __uint_as_float(gr.y & 0xFFFF0000u));
                *(u32x2*)(gp + e0) = ov;
            }
        }
        }
    }
    __syncthreads();
}

typedef const P __attribute__((address_space(4))) * KernargP;
__device__ __forceinline__ P load_params() {
#if defined(__HIP_DEVICE_COMPILE__)
    KernargP k = (KernargP)__builtin_amdgcn_kernarg_segment_ptr(); asm volatile("" : "+s"(k)); return *k;
#else
    return P{};
#endif
}
__global__ __launch_bounds__(512, 2) void mega(P p_unused, int pb, int pe, int rmask) {
    extern __shared__ __attribute__((aligned(16))) char smem[];
    cg::grid_group grid = cg::this_grid();
    float* fl = (float*)smem;
    for (int ph = pb; ph < pe; ++ph) {
      {
        const P p = load_params();
        switch (ph) {
            case 0: if (blockIdx.x == 0 && threadIdx.x == 0) *p.ctr = 0u; phase_mod(p, fl); __syncthreads(); phase_convert(p, fl); break;
            case 1: phase_norm(p, p.x, p.norm1_g, 0, 1024, p.h); break;
            case 2:
                run_gemm(smem, p.h, p.wt_in1, T, 4352, 1024, FastEpi<EpiP1>{EpiP1{p}});
                run_gemm(smem, p.h, p.wt_in2, T, 2048, 1024, FastEpi<EpiP2>{EpiP2{p}});
                run_gemm(smem, p.wt_gv, p.h, 2048, T, 1024, FastEpiVT{p.gvT, p.dvT});
                break;
            case 3: gla_prepass(p, smem); break;
            case 4:
                if (blockIdx.x < 128) gla_seq(p, smem, (int)blockIdx.x & 31, (int)blockIdx.x >> 5);
                attn_phase(p, smem);
                break;
            case 5:
                run_gemm(smem, p.gg, p.wt_glao, T, 1024, 1024, FastEpi<EpiM1>{EpiM1{p}});
                run_gemm(smem, p.h, p.wt_diffo, T, 1024, 1024, FastEpi<EpiMG>{EpiMG{p}});
                break;
            case 6: run_gemm(smem, p.merged, p.wt_out, T, 1024, 1024, FastEpi<EpiX1>{EpiX1{p}}); break;
            case 7: phase_norm_b(p, p.x1b, p.norm2_g, 3072, 4096, p.h); break;
            case 8: run_gemm(smem, p.h, p.wt_up, T, 5632, 1024, FastEpiUpConv{p, smem + 131072}); break;
            case 9: fixup_phase(p); break;
            case 10: run_gemm(smem, p.act, p.wt_down, T, 1024, 2816, FastEpi<EpiOut>{EpiOut{p}}); break;
        }
      }
        if (ph + 1 < pe) grid.sync();
#ifdef XSYNC
        for (int q = 0; q < XSYNC; ++q) grid.sync();
#endif
    }
}

constexpr size_t MEGA_LDS = 160 * 1024;
#ifndef RMASK
#define RMASK 0
#endif
static int g_grid = 0;
static void launch_mega(const P& p, int pb, int pe, hipStream_t stream) {
    P pp = p; int a = pb, b = pe, rm = RMASK;
    void* args[] = {&pp, &a, &b, &rm};
    hipError_t e = hipLaunchCooperativeKernel((const void*)mega, dim3(g_grid), dim3(512), args, MEGA_LDS, stream);
    if (e != hipSuccess) fprintf(stderr, "cooperative launch failed: %s (grid %d)\n", hipGetErrorString(e), g_grid);
}

extern "C" void kernel_launch(void* const* d_in, const int* in_sizes, int n_in, void* d_out, int out_size, void* d_ws, size_t ws_size, hipStream_t stream) {
    P p{};
    const float** f = (const float**)&p;
    for (int i = 0; i < 24; ++i) f[i] = (const float*)d_in[i];
    p.out = (float*)d_out;
    char* ws = (char*)d_ws; size_t off = 0;
    const size_t MiB = 1u << 20;
    auto take = [&](size_t bytes) { char* r = ws + off; off += (bytes + 255) & ~(size_t)255; return r; };
    p.wt_in1 = (bf16_t*)take((size_t)4352 * 1024 * 2); p.wt_in2 = (bf16_t*)take((size_t)2048 * 1024 * 2);
    p.wt_gv = (bf16_t*)take(2 * MiB); p.wt_dv = (bf16_t*)take(2 * MiB);
    p.wt_glao = (bf16_t*)take(2 * MiB); p.wt_diffo = (bf16_t*)take(2 * MiB); p.wt_out = (bf16_t*)take(2 * MiB);
    p.wt_up = (bf16_t*)take((size_t)5632 * 1024 * 2); p.wt_down = (bf16_t*)take((size_t)1024 * 2816 * 2);
    p.mod = (float*)take(8 * 6144 * 4);
    p.ctr = (unsigned*)take(256);
    off = 40 * MiB;
    p.h = (bf16_t*)take(64 * MiB);
    char* big = ws + off;
    p.gq = (bf16_t*)(big); p.gk = (bf16_t*)(big + 32 * MiB); p.gg = (bf16_t*)(big + 64 * MiB); p.gvT = (bf16_t*)(big + 128 * MiB);
    p.acode = (float*)(big + 192 * MiB); p.decay = (float*)(big + 192 * MiB); p.delta = (bf16_t*)(big + 194 * MiB);
    p.dq = (bf16_t*)(big + 194 * MiB); p.dk = (bf16_t*)(big + 258 * MiB); p.dvT = (bf16_t*)(big + 322 * MiB); p.merged = (bf16_t*)(big);
    p.uh = (bf16_t*)(big); p.act = (bf16_t*)(big + 128 * MiB); p.ubnd = (bf16_t*)(big + 386 * MiB); p.x1b = (bf16_t*)(big + 64 * MiB);
    p.kdtA = (bf16_t*)ws; p.kdtB = (bf16_t*)(big + 386 * MiB); p.decg = (float*)(big + 399 * MiB);
    p.sga = (bf16_t*)d_out; p.sgb = (bf16_t*)d_out + (size_t)T * 1024;
    if (ws_size < 496 * MiB) { fprintf(stderr, "workspace too small: %zu\n", ws_size); return; }

    if (!g_grid) {
        (void)hipFuncSetAttribute((const void*)mega, hipFuncAttributeMaxDynamicSharedMemorySize, (int)MEGA_LDS);
        int dev = 0, cus = 0, per_cu = 0;
        (void)hipGetDevice(&dev);
        (void)hipDeviceGetAttribute(&cus, hipDeviceAttributeMultiprocessorCount, dev);
        (void)hipOccupancyMaxActiveBlocksPerMultiprocessor(&per_cu, mega, 512, MEGA_LDS);
        if (per_cu < 1) per_cu = 1;
        g_grid = cus * per_cu;
    }
    launch_mega(p, 0, 11, stream);
}
```

```cpp
#include <hip/hip_runtime.h>
#include <hip/hip_cooperative_groups.h>
#include <cstdio>
namespace cg = cooperative_groups;

typedef unsigned short bf16_t;
typedef float f32x4 __attribute__((ext_vector_type(4)));
typedef unsigned u32x4 __attribute__((ext_vector_type(4)));
typedef unsigned u32x2 __attribute__((ext_vector_type(2)));

constexpr int T = 32768;
constexpr int DM = 1024;
constexpr int NIN = 8208;
constexpr float EPS = 1e-6f;
constexpr float LOG2E = 1.4426950408889634f;

__device__ __forceinline__ float bf2f(bf16_t v) { return __uint_as_float(((unsigned)v) << 16); }
__device__ __forceinline__ bf16_t f2bf(float f) { unsigned u = __float_as_uint(f); u += 0x7FFFu + ((u >> 16) & 1u); return (bf16_t)(u >> 16); }
typedef float f32x2v __attribute__((ext_vector_type(2)));
typedef __bf16 bf16x2v __attribute__((ext_vector_type(2)));
__device__ __forceinline__ unsigned pk2(float lo, float hi) { const f32x2v v = {lo, hi}; return __builtin_bit_cast(unsigned, __builtin_convertvector(v, bf16x2v)); }
__device__ __forceinline__ float siluf(float v) { return v * __builtin_amdgcn_rcpf(1.f + __builtin_amdgcn_exp2f(-LOG2E * v)); }
__device__ __forceinline__ float sigmf(float v) { return __builtin_amdgcn_rcpf(1.f + __builtin_amdgcn_exp2f(-LOG2E * v)); }
__device__ __forceinline__ float logsigf(float z) { return fminf(z, 0.f) - __logf(1.f + __expf(-fabsf(z))); }

__device__ __forceinline__ int otid() { int t = threadIdx.x; asm volatile("" : "+v"(t)); return t; }

struct P {
    const float *x, *c, *w_ada, *b_ada, *norm1_g, *w_in, *w_alpha_up, *b_alpha, *gla_norm_g, *q_norm_g, *k_norm_g,
        *lam_q1, *lam_k1, *lam_q2, *lam_k2, *diff_norm_g, *w_gla_o, *w_diff_o, *w_out, *norm2_g, *w_up, *conv_w, *conv_b, *w_down;
    float* out;
    bf16_t *wt_in1, *wt_in2, *wt_gv, *wt_dv, *wt_glao, *wt_diffo, *wt_out, *wt_up, *wt_down;
    float* mod;
    bf16_t* h;
    bf16_t *gq, *gk, *gg, *gvT;
    float *acode, *decay;
    bf16_t* delta;
    bf16_t *dq, *dk, *dvT, *merged, *uh, *act;
    bf16_t *sga, *sgb;
    unsigned* ctr;
    bf16_t* ubnd;
    bf16_t *kdtA, *kdtB; float* decg;
    bf16_t* x1b;
};

__host__ __device__ __forceinline__ int tperm(int q, int style) {
    const int bj = q >> 7, wc = (q >> 5) & 3, n = (q >> 4) & 1, fq = (q >> 2) & 3, j = q & 3;
    return style == 0 ? 64 * wc + 32 * bj + 8 * fq + 4 * n + j : 64 * wc + 16 * (2 * bj + n) + 4 * fq + j;
}
__host__ __device__ __forceinline__ int src_logical(int kind, int L) {
    switch (kind) {
        case 0:
            if (L < 1024) return L;
            if (L < 2048) return 2048 + (L - 1024);
            if (L < 3072) return 6160 + (L - 2048);
            if (L < 4096) return 7184 + (L - 3072);
            return (L - 4096) < 16 ? 3072 + (L - 4096) : -1;
        case 1:
            return L < 1024 ? 3088 + L : 4112 + (L - 1024);
        case 4: case 6: return L;
        case 5: { const int ch = 128 * (L >> 8) + ((L & 255) >> 1); return (L & 1) * 2816 + ch; }
    }
    return -1;
}
__host__ __device__ __forceinline__ int src_physical(int kind, int prow) {
    if (kind == 2) return 1024 + prow;
    if (kind == 3) return 5136 + prow;
    return src_logical(kind, (prow & ~255) + tperm(prow & 255, kind == 6 ? 1 : 0));
}

struct RedNaive { static __device__ __forceinline__ float sum4(float x) { x += __shfl_xor(x, 1); x += __shfl_xor(x, 2); return x; } };
struct RedFast  { static __device__ __forceinline__ float sum4(float x) { x += __shfl_xor(x, 16); x += __shfl_xor(x, 32); return x; } };

__device__ __forceinline__ void st16_bf16(bf16_t* dst, const float (&v)[16]) {
    u32x4 a, b;
    a.x = pk2(v[0], v[1]); a.y = pk2(v[2], v[3]); a.z = pk2(v[4], v[5]); a.w = pk2(v[6], v[7]);
    b.x = pk2(v[8], v[9]); b.y = pk2(v[10], v[11]); b.z = pk2(v[12], v[13]); b.w = pk2(v[14], v[15]);
    *(u32x4*)dst = a; *(u32x4*)(dst + 8) = b;
}
__device__ __forceinline__ void st8x2_bf16(bf16_t* dst, const float (&v)[16]) {
    u32x4 a, b;
    a.x = pk2(v[0], v[1]); a.y = pk2(v[2], v[3]); a.z = pk2(v[4], v[5]); a.w = pk2(v[6], v[7]);
    b.x = pk2(v[8], v[9]); b.y = pk2(v[10], v[11]); b.z = pk2(v[12], v[13]); b.w = pk2(v[14], v[15]);
    *(u32x4*)dst = a; *(u32x4*)(dst + 32) = b;
}
__device__ __forceinline__ void ld16_bf16(const bf16_t* src, float (&v)[16]) {
    const u32x4 a = *(const u32x4*)src, b = *(const u32x4*)(src + 8);
    const unsigned w[8] = {a.x, a.y, a.z, a.w, b.x, b.y, b.z, b.w};
#pragma unroll
    for (int i = 0; i < 8; ++i) { v[2 * i] = __uint_as_float(w[i] << 16); v[2 * i + 1] = __uint_as_float(w[i] & 0xFFFF0000u); }
}

__device__ __forceinline__ void unpack16(const u32x4& a, const u32x4& b, float (&v)[16]) {
    const unsigned w[8] = {a.x, a.y, a.z, a.w, b.x, b.y, b.z, b.w};
#pragma unroll
    for (int i = 0; i < 8; ++i) { v[2 * i] = __uint_as_float(w[i] << 16); v[2 * i + 1] = __uint_as_float(w[i] & 0xFFFF0000u); }
}
struct NoCtx {};
struct EpiP1 {
    static constexpr int STYLE = 0;
    P p;
    typedef NoCtx Ctx; typedef NoCtx Pre;
    __device__ __forceinline__ void begin(int seg, int c16, Ctx&) const {}
    __device__ __forceinline__ void pre(int seg, int row, int c16, Pre&) const {}
    __device__ __forceinline__ void fin(int seg, int row, int c16, float (&v)[16], const Pre&, const Ctx&) const {
        if (seg < 2) { st8x2_bf16(p.gq + (size_t)row * 512 + c16, v); }
        else if (seg < 4) { st8x2_bf16(p.gk + (size_t)row * 512 + (c16 - 512), v); }
        else if (seg < 8) {
#pragma unroll
            for (int i = 0; i < 16; ++i) v[i] = siluf(v[i]);
            st8x2_bf16(p.gg + (size_t)row * 1024 + (c16 - 1024), v);
        } else if (seg < 16) {
#pragma unroll
            for (int i = 0; i < 16; ++i) v[i] = sigmf(v[i]);
            bf16_t* dst = seg < 12 ? p.sga + (size_t)row * 1024 + (c16 - 2048) : p.sgb + (size_t)row * 1024 + (c16 - 3072);
            st8x2_bf16(dst, v);
        } else if (c16 == 4096 || c16 == 4104) {
            float* dst = p.acode + (size_t)row * 16 + (c16 - 4096);
            *(f32x4*)dst = (f32x4){v[0], v[1], v[2], v[3]}; *(f32x4*)(dst + 4) = (f32x4){v[4], v[5], v[6], v[7]};
        }
    }
};
struct EpiP2 {
    static constexpr int STYLE = 0;
    P p;
    struct Ctx { float g[16]; };
    typedef NoCtx Pre;
    __device__ __forceinline__ void begin(int seg, int c16, Ctx& c) const {
        const float* g = (seg < 4 ? p.q_norm_g : p.k_norm_g) + (c16 & 63); const float sc = seg < 4 ? 0.125f * LOG2E : 1.f;
#pragma unroll
        for (int i = 0; i < 8; ++i) { c.g[i] = g[i] * sc; c.g[8 + i] = g[32 + i] * sc; }
    }
    __device__ __forceinline__ void pre(int seg, int row, int c16, Pre&) const {}
    __device__ __forceinline__ void fin(int seg, int row, int c16, float (&v)[16], const Pre&, const Ctx& c) const {
        float ss = 0.f;
#pragma unroll
        for (int i = 0; i < 16; ++i) ss += v[i] * v[i];
        ss = RedFast::sum4(ss);
        const float rstd = rsqrtf(ss * (1.f / 64.f) + EPS);
#pragma unroll
        for (int i = 0; i < 16; ++i) v[i] = v[i] * rstd * c.g[i];
        bf16_t* dst = seg < 4 ? p.dq + (size_t)row * 1024 + c16 : p.dk + (size_t)row * 1024 + (c16 - 1024);
        st8x2_bf16(dst, v);
    }
};
struct EpiM1 {
    static constexpr int STYLE = 0;
    P p;
    typedef NoCtx Ctx; struct Pre { u32x4 a, b; };
    __device__ __forceinline__ void begin(int seg, int c16, Ctx&) const {}
    __device__ __forceinline__ void pre(int seg, int row, int c16, Pre& q) const { const bf16_t* s = p.sga + (size_t)row * 1024 + c16; q.a = *(const u32x4*)s; q.b = *(const u32x4*)(s + 32); }
    __device__ __forceinline__ void fin(int seg, int row, int c16, float (&v)[16], const Pre& q, const Ctx&) const {
        float g[16]; unpack16(q.a, q.b, g);
#pragma unroll
        for (int i = 0; i < 16; ++i) v[i] *= g[i];
        st8x2_bf16(p.merged + (size_t)row * 1024 + c16, v);
    }
};
struct EpiMG {
    static constexpr int STYLE = 0;
    P p;
    typedef NoCtx Ctx; struct Pre { u32x4 a, b, c, d; };
    __device__ __forceinline__ void begin(int seg, int c16, Ctx&) const {}
    __device__ __forceinline__ void pre(int seg, int row, int c16, Pre& q) const {
        const bf16_t* s = p.sgb + (size_t)row * 1024 + c16; const bf16_t* m = p.merged + (size_t)row * 1024 + c16;
        q.a = *(const u32x4*)s; q.b = *(const u32x4*)(s + 32); q.c = *(const u32x4*)m; q.d = *(const u32x4*)(m + 32);
    }
    __device__ __forceinline__ void fin(int seg, int row, int c16, float (&v)[16], const Pre& q, const Ctx&) const {
        float g[16], m[16]; unpack16(q.a, q.b, g); unpack16(q.c, q.d, m);
#pragma unroll
        for (int i = 0; i < 16; ++i) v[i] = m[i] + g[i] * v[i];
        st8x2_bf16(p.merged + (size_t)row * 1024 + c16, v);
    }
};
struct EpiRes {
    static constexpr int STYLE = 1;
    P p; const float* src; float* dst; int goff; int pad;
    struct Ctx { f32x4 g[4]; }; struct Pre { f32x4 x[4]; };
    __device__ __forceinline__ void begin(int seg, int c16, Ctx&) const {}
    __device__ __forceinline__ void pre(int seg, int row, int c16, Pre& q) const {
        const float* s = src + (size_t)row * 1024 + c16;
#pragma unroll
        for (int i = 0; i < 4; ++i) q.x[i] = *(const f32x4*)(s + 16 * i);
    }
    __device__ __forceinline__ void fin(int seg, int row, int c16, float (&v)[16], const Pre& q, const Ctx&) const {
        const float* gt = p.mod + (size_t)(row >> 12) * 6144 + goff + c16;
        float* d = dst + (size_t)row * 1024 + c16;
#pragma unroll
        for (int i = 0; i < 4; ++i) {
            const f32x4 gv = *(const f32x4*)(gt + 16 * i);
            f32x4 o; o.x = q.x[i].x + gv.x * v[4 * i]; o.y = q.x[i].y + gv.y * v[4 * i + 1]; o.z = q.x[i].z + gv.z * v[4 * i + 2]; o.w = q.x[i].w + gv.w * v[4 * i + 3];
            *(f32x4*)(d + 16 * i) = o;
        }
    }
};
struct EpiX1 {
    static constexpr int STYLE = 0;
    P p;
    typedef NoCtx Ctx; struct Pre { f32x4 x[4]; };
    __device__ __forceinline__ void begin(int seg, int c16, Ctx&) const {}
    __device__ __forceinline__ void pre(int seg, int row, int c16, Pre& q) const {
        const float* s = p.x + (size_t)row * 1024 + c16;
        q.x[0] = __builtin_nontemporal_load((const f32x4*)s); q.x[1] = __builtin_nontemporal_load((const f32x4*)(s + 4)); q.x[2] = __builtin_nontemporal_load((const f32x4*)(s + 32)); q.x[3] = __builtin_nontemporal_load((const f32x4*)(s + 36));
    }
    __device__ __forceinline__ void fin(int seg, int row, int c16, float (&v)[16], const Pre& q, const Ctx&) const {
        const float* gt = p.mod + (size_t)(row >> 12) * 6144 + 2048 + c16;
#pragma unroll
        for (int i = 0; i < 4; ++i) {
            const f32x4 gv = *(const f32x4*)(gt + (i >> 1) * 32 + (i & 1) * 4);
            v[4 * i] = q.x[i].x + gv.x * v[4 * i]; v[4 * i + 1] = q.x[i].y + gv.y * v[4 * i + 1]; v[4 * i + 2] = q.x[i].z + gv.z * v[4 * i + 2]; v[4 * i + 3] = q.x[i].w + gv.w * v[4 * i + 3];
        }
        st8x2_bf16(p.x1b + (size_t)row * 1024 + c16, v);
    }
};
struct EpiOut {
    static constexpr int STYLE = 1;
    P p;
    typedef NoCtx Ctx; struct Pre { u32x2 x[4]; };
    __device__ __forceinline__ void begin(int seg, int c16, Ctx&) const {}
    __device__ __forceinline__ void pre(int seg, int row, int c16, Pre& q) const {
        const bf16_t* s = p.x1b + (size_t)row * 1024 + c16;
#pragma unroll
        for (int i = 0; i < 4; ++i) q.x[i] = *(const u32x2*)(s + 16 * i);
    }
    __device__ __forceinline__ void fin(int seg, int row, int c16, float (&v)[16], const Pre& q, const Ctx&) const {
        const float* gt = p.mod + (size_t)(row >> 12) * 6144 + 5120 + c16;
        float* d = p.out + (size_t)row * 1024 + c16;
#pragma unroll
        for (int i = 0; i < 4; ++i) {
            const f32x4 gv = *(const f32x4*)(gt + 16 * i);
            f32x4 o;
            o.x = __uint_as_float(q.x[i].x << 16) + gv.x * v[4 * i]; o.y = __uint_as_float(q.x[i].x & 0xFFFF0000u) + gv.y * v[4 * i + 1];
            o.z = __uint_as_float(q.x[i].y << 16) + gv.z * v[4 * i + 2]; o.w = __uint_as_float(q.x[i].y & 0xFFFF0000u) + gv.w * v[4 * i + 3];
            *(f32x4*)(d + 16 * i) = o;
        }
    }
};
struct EpiUp {
    static constexpr int STYLE = 0;
    P p;
    typedef NoCtx Ctx; typedef NoCtx Pre;
    __device__ __forceinline__ void begin(int seg, int c16, Ctx&) const {}
    __device__ __forceinline__ void pre(int seg, int row, int c16, Pre&) const {}
    __device__ __forceinline__ void fin(int seg, int row, int c16, float (&v)[16], const Pre&, const Ctx&) const { st8x2_bf16(p.uh + (size_t)row * 2816 + c16, v); }
};

namespace pg8 {
#define PG8_LAS __attribute__((address_space(3)))
typedef unsigned short bf16_t;
typedef short bf16x8 __attribute__((ext_vector_type(8)));
typedef float f32x4 __attribute__((ext_vector_type(4)));
typedef unsigned u32x4 __attribute__((ext_vector_type(4)));
constexpr int BM = 256, BK = 64, HALF = 128, HTB = HALF * BK * 2  , STAGE_BYTES = 8 * HTB, NXCD = 8, WGM = 8;

__host__ __device__ __forceinline__ int lds_byte(int r, int c) { const int st = (r >> 4) * 2 + (c >> 5), rr = r & 15, cc = c & 31, ob = rr * 64 + cc * 2; return st * 1024 + (ob ^ (((ob >> 9) & 1) << 5)); }
__host__ __device__ __forceinline__ void stage_rc(int b, int& R, int& C) { const int st = b / 1024, sb = b % 1024, swz = sb ^ (((sb >> 9) & 1) << 5); R = (st >> 1) * 16 + swz / 64; C = (st & 1) * 32 + (swz % 64) / 2; }
__host__ __device__ __forceinline__ int perm32(int rho) { const int n = rho >> 4, i = rho & 15; return 8 * (i >> 2) + 4 * n + (i & 3); }

struct Unit { int pm, pn; };
struct Gemm { const bf16_t* A; const bf16_t* Bt; int M, N, K; };

struct StaticOrder {
    int nM, nN, nwg, G, c;
    __host__ __device__ void init(int M, int N, int G_, int c_) { nM = M / BM; nN = N / BM; nwg = nM * nN; G = G_; c = c_; }
    __host__ __device__ bool next(int i, Unit& u) const {
        const long L = (long)i * G + c; if (L >= nwg) return false;
        int wgid = (int)L; { const int q = nwg / NXCD, r = nwg % NXCD, xcd = wgid % NXCD, off = wgid / NXCD; wgid = (xcd < r ? xcd * (q + 1) : r * (q + 1) + (xcd - r) * q) + off; }
        const int nig = WGM * nN, gid = wgid / nig, fm = gid * WGM, gsz = (nM - fm) < WGM ? (nM - fm) : WGM;
        u.pm = fm + ((wgid % nig) % gsz); u.pn = (wgid % nig) / gsz; return true;
    }
    __device__ __forceinline__ void a_ready(const Unit&) const {}
    __device__ __forceinline__ void done(const Unit&) const {}
};

template <class Epi, class Sched, bool STAMP = false>
__device__ __forceinline__ void gemm_phase(PG8_LAS unsigned char* lds, const Gemm g, const Sched& S, const Epi& E, unsigned long long* stamps) {
    int tid_ = threadIdx.x; asm volatile("" : "+v"(tid_));
    const int tid = tid_, wid = __builtin_amdgcn_readfirstlane(tid >> 6), lane = tid & 63, wr = wid >> 2, wc = wid & 3, fr = lane & 15, fq = lane >> 4;
    const int K = g.K, nt = K / BK;
    int ts_lo = 0, ts_hi = 0, nts = 0; const unsigned long long rt_entry = STAMP ? (unsigned long long)wall_clock64() : 0ull;
#define PG8_STAMP() do { if (STAMP && wid == 0 && nts < 64) { const unsigned long long _c = (unsigned long long)clock64(); \
        ts_lo = (lane == nts) ? (int)(unsigned)_c : ts_lo; ts_hi = (lane == nts) ? (int)(unsigned)(_c >> 32) : ts_hi; ++nts; } } while (0)
    PG8_STAMP();
    unsigned voffA[2], voffB[2];
#pragma unroll
    for (int i = 0; i < 2; ++i) { int R, C; stage_rc(tid * 16 + i * 8192, R, C); const int Rb = Epi::PERM ? ((R & ~31) + perm32(R & 31)) : R;
        voffA[i] = (unsigned)(R * K + C) * 2u; voffB[i] = (unsigned)(Rb * K + C) * 2u; }
    const size_t kstep = (size_t)(BK * 2);
    const size_t hstep = (size_t)HALF * K * 2;
    const size_t tstep = 2 * hstep;
    const unsigned ldsw = (unsigned)wid * 1024u;
    const int aoff = lds_byte(wr * 64 + fr, fq * 8), boff = lds_byte(wc * 32 + fr, fq * 8);
#define PG8_SA(b, h) (((b) * 2 + (h)) * HTB)
#define PG8_SB(b, h) ((4 + (b) * 2 + (h)) * HTB)
#define PG8_STAGE(bufoff, gbase, voff) do { _Pragma("unroll") for (int _i = 0; _i < 2; ++_i) \
        __builtin_amdgcn_global_load_lds((const unsigned*)((const char*)(gbase) + (voff)[_i]), (PG8_LAS unsigned*)(lds + (bufoff) + ldsw + _i * 8192), 16, 0, 0); } while (0)
#define PG8_LDA(dst, b, h) do { _Pragma("unroll") for (int m = 0; m < 4; ++m) _Pragma("unroll") for (int k = 0; k < 2; ++k) dst[m][k] = *(const PG8_LAS bf16x8*)(lds + PG8_SA(b, h) + aoff + m * 2048 + k * 1024); } while (0)
#define PG8_LDB(dst, b, h) do { _Pragma("unroll") for (int n = 0; n < 2; ++n) _Pragma("unroll") for (int k = 0; k < 2; ++k) dst[n][k] = *(const PG8_LAS bf16x8*)(lds + PG8_SB(b, h) + boff + n * 2048 + k * 1024); } while (0)
#define PG8_MMA(ai, bj, At, Bt) do { __builtin_amdgcn_s_setprio(1); _Pragma("unroll") for (int m = 0; m < 4; ++m) _Pragma("unroll") for (int n = 0; n < 2; ++n) _Pragma("unroll") for (int k = 0; k < 2; ++k) \
        acc[ai][bj][m][n] = __builtin_amdgcn_mfma_f32_16x16x32_bf16(Bt[n][k], At[m][k], acc[ai][bj][m][n], 0, 0, 0); __builtin_amdgcn_s_setprio(0); } while (0)
#define PG8_WAIT_V(n) asm volatile("s_waitcnt vmcnt(" #n ")" ::: "memory")
#define PG8_WAIT_L(n) asm volatile("s_waitcnt lgkmcnt(" #n ")" ::: "memory")
#define PG8_BAR __builtin_amdgcn_s_barrier()
#define PG8_SCHED __builtin_amdgcn_sched_barrier(0)
    Unit cur, nxt; int ui = 0;
    if (!S.next(0, cur)) return;
    f32x4 acc[2][2][4][2];
#pragma unroll
    for (int a = 0; a < 2; ++a)
#pragma unroll
        for (int b = 0; b < 2; ++b)
#pragma unroll
            for (int m = 0; m < 4; ++m)
#pragma unroll
                for (int n = 0; n < 2; ++n) acc[a][b][m][n] = (f32x4){0.f, 0.f, 0.f, 0.f};
    bf16x8 At[4][2], B0[2][2], B1[2][2];
    const char* cA = (const char*)g.A + (size_t)cur.pm * tstep; const char* cB = (const char*)g.Bt + (size_t)cur.pn * tstep;
    S.a_ready(cur);
    PG8_STAGE(PG8_SB(0, 0), cB, voffB); PG8_STAGE(PG8_SA(0, 0), cA, voffA); PG8_STAGE(PG8_SB(0, 1), cB + hstep, voffB); PG8_STAGE(PG8_SA(0, 1), cA + hstep, voffA);
    if (wr == 1) PG8_BAR;
    PG8_WAIT_V(4); PG8_BAR;
    PG8_STAGE(PG8_SB(1, 0), cB + kstep, voffB); PG8_STAGE(PG8_SA(1, 0), cA + kstep, voffA); PG8_STAGE(PG8_SB(1, 1), cB + hstep + kstep, voffB);
    PG8_WAIT_V(6); PG8_BAR;
    PG8_STAMP();
#ifndef KREP
#define KREP 1
#endif
    int krep = 0;
    for (;;) {
        const bool adv = (krep == KREP - 1);
        bool has_next = true;
        if (adv) has_next = S.next(ui + 1, nxt); else nxt = cur;
        const char* nA = has_next ? (const char*)g.A + (size_t)nxt.pm * tstep : cA; const char* nB = has_next ? (const char*)g.Bt + (size_t)nxt.pn * tstep : cB;
        for (int t = 0; t < nt; t += 2) {
            const bool last = (t == nt - 2);
            const char* a1 = cA + (size_t)(t + 1) * kstep;
            const char* a2 = last ? nA : cA + (size_t)(t + 2) * kstep; const char* b2 = last ? nB : cB + (size_t)(t + 2) * kstep;
            const char* a3 = a2 + kstep; const char* b3 = b2 + kstep;
            if (last && has_next) S.a_ready(nxt);
            PG8_LDB(B0, 0, 0); PG8_SCHED; PG8_LDA(At, 0, 0); PG8_STAGE(PG8_SA(1, 1), a1 + hstep, voffA);
            PG8_WAIT_L(8); PG8_BAR; PG8_WAIT_L(0); PG8_MMA(0, 0, At, B0); PG8_BAR; PG8_SCHED;
            PG8_LDB(B1, 0, 1); PG8_STAGE(PG8_SB(0, 0), b2, voffB);
            PG8_BAR; PG8_WAIT_L(0); PG8_MMA(0, 1, At, B1); PG8_BAR;
            PG8_LDA(At, 0, 1); PG8_STAGE(PG8_SA(0, 0), a2, voffA);
            PG8_BAR; PG8_WAIT_L(0); PG8_MMA(1, 0, At, B0); PG8_BAR; PG8_SCHED;
            PG8_STAGE(PG8_SB(0, 1), b2 + hstep, voffB);
            PG8_WAIT_V(6); PG8_BAR; PG8_MMA(1, 1, At, B1); PG8_BAR;
            PG8_LDB(B0, 1, 0); PG8_SCHED; PG8_LDA(At, 1, 0); PG8_STAGE(PG8_SA(0, 1), a2 + hstep, voffA);
            PG8_WAIT_L(8); PG8_BAR; PG8_WAIT_L(0); PG8_MMA(0, 0, At, B0); PG8_BAR; PG8_SCHED;
            PG8_LDB(B1, 1, 1); PG8_STAGE(PG8_SB(1, 0), b3, voffB);
            PG8_BAR; PG8_WAIT_L(0); PG8_MMA(0, 1, At, B1); PG8_BAR;
            PG8_LDA(At, 1, 1); PG8_STAGE(PG8_SA(1, 0), a3, voffA);
            PG8_BAR; PG8_WAIT_L(0); PG8_MMA(1, 0, At, B0); PG8_BAR; PG8_SCHED;
            PG8_STAGE(PG8_SB(1, 1), b3 + hstep, voffB);
            PG8_WAIT_V(6); PG8_BAR; PG8_MMA(1, 1, At, B1); PG8_BAR;
        }
        PG8_STAMP();
        if (!adv) {
            ++krep;
#pragma unroll
            for (int a = 0; a < 2; ++a)
#pragma unroll
                for (int b = 0; b < 2; ++b)
#pragma unroll
                    for (int m = 0; m < 4; ++m)
#pragma unroll
                        for (int n = 0; n < 2; ++n) acc[a][b][m][n] = (f32x4){0.f, 0.f, 0.f, 0.f};
            continue;
        }
        krep = 0;
        if constexpr (!Epi::AFTER_DRAIN) { E(acc, cur, wr, wc, fr, fq); S.done(cur); }
        PG8_STAMP();
        if (!has_next) break;
#pragma unroll
        for (int a = 0; a < 2; ++a)
#pragma unroll
            for (int b = 0; b < 2; ++b)
#pragma unroll
                for (int m = 0; m < 4; ++m)
#pragma unroll
                    for (int n = 0; n < 2; ++n) acc[a][b][m][n] = (f32x4){0.f, 0.f, 0.f, 0.f};
        cur = nxt; cA = nA; cB = nB; ++ui;
    }
    PG8_WAIT_V(0);
    if (wr == 0) PG8_BAR;
    PG8_BAR;
    if constexpr (Epi::AFTER_DRAIN) { E.fused(acc, cur, wr, wc, fr, fq, lds, wid, lane); S.done(cur); }
    PG8_STAMP();
    if (STAMP && wid == 0) { stamps[lane] = lane < nts ? (((unsigned long long)(unsigned)ts_hi << 32) | (unsigned)ts_lo) : 0ull;
        if (lane == 62) stamps[62] = rt_entry; if (lane == 63) stamps[63] = (unsigned long long)wall_clock64(); }
#undef PG8_STAMP
#undef PG8_SA
#undef PG8_SB
#undef PG8_STAGE
#undef PG8_LDA
#undef PG8_LDB
#undef PG8_MMA
#undef PG8_WAIT_V
#undef PG8_WAIT_L
#undef PG8_BAR
#undef PG8_SCHED
}
}


template <class EPI> struct FastEpi {
    static constexpr bool PERM = false, AFTER_DRAIN = false;
    EPI e;
    __device__ __forceinline__ void operator()(const pg8::f32x4 (&acc)[2][2][4][2], const pg8::Unit& u, int wr, int wc, int fr, int fq) const {
        const int c16 = u.pn * 256 + 64 * wc + (EPI::STYLE == 0 ? 8 : 4) * fq, seg = u.pn;
        const int row0 = u.pm * 256 + wr * 64 + fr;
        typename EPI::Ctx ctx; e.begin(seg, c16, ctx);
        typename EPI::Pre pre[2][2];
        e.pre(seg, row0, c16, pre[0][0]); e.pre(seg, row0 + 16, c16, pre[0][1]);
#pragma unroll
        for (int bt = 0; bt < 4; ++bt) {
            if (bt < 3) {
                const int k = 2 * bt + 2;
                e.pre(seg, row0 + (k >> 2) * 128 + (k & 3) * 16, c16, pre[(bt + 1) & 1][0]); e.pre(seg, row0 + (k >> 2) * 128 + ((k + 1) & 3) * 16, c16, pre[(bt + 1) & 1][1]);
            }
#pragma unroll
            for (int r = 0; r < 2; ++r) {
                const int k = 2 * bt + r, ai = k >> 2, m = k & 3;
                float v[16];
#pragma unroll
                for (int bj = 0; bj < 2; ++bj)
#pragma unroll
                    for (int n = 0; n < 2; ++n)
#pragma unroll
                        for (int j = 0; j < 4; ++j) v[8 * bj + 4 * n + j] = acc[ai][bj][m][n][j];
                e.fin(seg, row0 + ai * 128 + m * 16, c16, v, pre[bt & 1][r], ctx);
            }
        }
    }
};
struct FastEpiUpConv {
    static constexpr bool PERM = false, AFTER_DRAIN = false;
    P p; char* xh;
    __device__ __forceinline__ void operator()(const pg8::f32x4 (&acc)[2][2][4][2], const pg8::Unit& u, int wr, int wc, int fr, int fq) const {
        const int lane = 16 * fq + fr;
        const int src1 = (lane & 48) | ((fr + 15) & 15), src2 = (lane & 48) | ((fr + 14) & 15);
        const int ch0 = 128 * u.pn + 32 * wc + 4 * fq;
        const int row0 = u.pm * 256 + wr * 64 + fr;
        float* xhf = (float*)xh;
        if (fr >= 14) {
#pragma unroll
            for (int ai = 0; ai < 2; ++ai) {
                float* d = xhf + ((((ai * 2 + wr) * 4 + wc) * 4 + fq) * 2 + (fr - 14)) * 16;
#pragma unroll
                for (int bj = 0; bj < 2; ++bj)
#pragma unroll
                    for (int n = 0; n < 2; ++n) *(f32x4*)(d + 8 * bj + 4 * n) = acc[ai][bj][3][n];
            }
        }
        {
            const bool top = (wr == 0 && fr < 2), bot = (wr == 1 && fr >= 14);
            if (top || bot) {
                const int ai = top ? 0 : 1, m = top ? 0 : 3, rsel = top ? fr : fr - 12;
                float v[16];
#pragma unroll
                for (int bj = 0; bj < 2; ++bj)
#pragma unroll
                    for (int n = 0; n < 2; ++n)
#pragma unroll
                        for (int j = 0; j < 4; ++j) v[8 * bj + 4 * n + j] = top ? acc[0][bj][0][n][j] : acc[1][bj][3][n][j];
                (void)ai; (void)m;
                st8x2_bf16(p.ubnd + ((size_t)u.pm * 4 + rsel) * 5632 + u.pn * 256 + 64 * wc + 8 * fq, v);
            }
        }
        asm volatile("s_waitcnt lgkmcnt(0)" ::: "memory");
        __builtin_amdgcn_s_barrier(); __builtin_amdgcn_s_barrier();
        asm volatile("" ::: "memory");
#pragma unroll
        for (int hf = 0; hf < 2; ++hf) {
            const int ch = ch0 + 16 * hf;
            float wa[3][4], wb[3][4], ba[4], bb[4];
#pragma unroll
            for (int j = 0; j < 3; ++j) {
                const f32x4 a = *(const f32x4*)(p.conv_w + j * 5632 + ch), b = *(const f32x4*)(p.conv_w + j * 5632 + 2816 + ch);
                wa[j][0] = a.x; wa[j][1] = a.y; wa[j][2] = a.z; wa[j][3] = a.w; wb[j][0] = b.x; wb[j][1] = b.y; wb[j][2] = b.z; wb[j][3] = b.w;
            }
            { const f32x4 a = *(const f32x4*)(p.conv_b + ch), b = *(const f32x4*)(p.conv_b + 2816 + ch); ba[0] = a.x; ba[1] = a.y; ba[2] = a.z; ba[3] = a.w; bb[0] = b.x; bb[1] = b.y; bb[2] = b.z; bb[3] = b.w; }
#pragma unroll
            for (int ai = 0; ai < 2; ++ai) {
                float t1p[8], t2p[8];
                {
                    const int pb = 2 * ai + wr - 1;
                    if (pb >= 0) {
                        const float* hsrc = xhf + (((pb * 4 + wc) * 4 + fq) * 2) * 16 + 8 * hf;
#pragma unroll
                        for (int k = 0; k < 8; ++k) { const float h2 = hsrc[k], h1 = hsrc[16 + k]; t1p[k] = h1; t2p[k] = fr == 0 ? h2 : h1; }
                    } else {
#pragma unroll
                        for (int k = 0; k < 8; ++k) { t1p[k] = 0.f; t2p[k] = 0.f; }
                    }
                }
#pragma unroll
                for (int m = 0; m < 4; ++m) {
                    float o[4];
#pragma unroll
                    for (int i = 0; i < 4; ++i) {
                        float cur[2], p1[2], p2[2];
#pragma unroll
                        for (int ab = 0; ab < 2; ++ab) {
                            const int k = 2 * i + ab;
                            const float v = acc[ai][hf][m][k >> 2][k & 3];
                            const float t1 = __shfl(v, src1), t2 = __shfl(v, src2);
                            cur[ab] = v; p1[ab] = fr == 0 ? t1p[k] : t1; p2[ab] = fr < 2 ? t2p[k] : t2;
                            t1p[k] = t1; t2p[k] = t2;
                        }
                        const float ca = wa[0][i] * p2[0] + wa[1][i] * p1[0] + wa[2][i] * cur[0] + ba[i];
                        const float cb = wb[0][i] * p2[1] + wb[1][i] * p1[1] + wb[2][i] * cur[1] + bb[i];
                        o[i] = siluf(ca) * cb;
                    }
                    u32x2 ov; ov.x = pk2(o[0], o[1]); ov.y = pk2(o[2], o[3]);
                    *(u32x2*)(p.act + (size_t)(row0 + ai * 128 + m * 16) * 2816 + ch) = ov;
                }
            }
        }
    }
};
__device__ __forceinline__ void fixup_phase(const P& p) {
    const int t_ = otid();
    for (int task = blockIdx.x * 512 + t_; task < 128 * 704; task += gridDim.x * 512) {
        const int pm = task / 704, rem = task % 704, rsel = rem / 352, cg = rem % 352;
        const int ch0 = cg * 8, col = (ch0 >> 7) * 256 + 2 * (ch0 & 127);
        float c0[16], c1[16], h1[16], h2[16];
        ld16_bf16(p.ubnd + ((size_t)pm * 4 + 0) * 5632 + col, c0); ld16_bf16(p.ubnd + ((size_t)pm * 4 + 1) * 5632 + col, c1);
        if (pm & 15) { ld16_bf16(p.ubnd + ((size_t)(pm - 1) * 4 + 3) * 5632 + col, h1); ld16_bf16(p.ubnd + ((size_t)(pm - 1) * 4 + 2) * 5632 + col, h2); }
        else {
#pragma unroll
            for (int k = 0; k < 16; ++k) { h1[k] = 0.f; h2[k] = 0.f; }
        }
        float o[8];
#pragma unroll
        for (int i = 0; i < 8; ++i) {
            const int ch = ch0 + i;
            const float a2 = rsel ? h1[2 * i] : h2[2 * i], a1 = rsel ? c0[2 * i] : h1[2 * i], a0 = rsel ? c1[2 * i] : c0[2 * i];
            const float b2 = rsel ? h1[2 * i + 1] : h2[2 * i + 1], b1 = rsel ? c0[2 * i + 1] : h1[2 * i + 1], b0 = rsel ? c1[2 * i + 1] : c0[2 * i + 1];
            const float ca = p.conv_w[ch] * a2 + p.conv_w[5632 + ch] * a1 + p.conv_w[2 * 5632 + ch] * a0 + p.conv_b[ch];
            const float cb = p.conv_w[2816 + ch] * b2 + p.conv_w[5632 + 2816 + ch] * b1 + p.conv_w[2 * 5632 + 2816 + ch] * b0 + p.conv_b[2816 + ch];
            o[i] = siluf(ca) * cb;
        }
        u32x4 ov; ov.x = pk2(o[0], o[1]); ov.y = pk2(o[2], o[3]); ov.z = pk2(o[4], o[5]); ov.w = pk2(o[6], o[7]);
        *(u32x4*)(p.act + ((size_t)pm * 256 + rsel) * 2816 + ch0) = ov;
    }
}
struct FastEpiVT {
    static constexpr bool PERM = false, AFTER_DRAIN = false, PROBE_TWICE = false;
    bf16_t* gdst; bf16_t* ddst;
    __device__ __forceinline__ void operator()(const pg8::f32x4 (&acc)[2][2][4][2], const pg8::Unit& u, int wr, int wc, int fr, int fq) const {
        const bool gla = u.pm < 4;
#pragma unroll
        for (int ai = 0; ai < 2; ++ai)
#pragma unroll
            for (int m = 0; m < 4; ++m) {
                const size_t row = (size_t)((u.pm & 3) * 256 + ai * 128 + wr * 64 + m * 16 + fr);
#pragma unroll
                for (int bj = 0; bj < 2; ++bj)
#pragma unroll
                    for (int n = 0; n < 2; ++n) {
                        const int col = u.pn * 256 + bj * 128 + wc * 32 + n * 16 + 4 * fq;
                        u32x2 o; o.x = pk2(acc[ai][bj][m][n][0], acc[ai][bj][m][n][1]); o.y = pk2(acc[ai][bj][m][n][2], acc[ai][bj][m][n][3]);
                        bf16_t* dst = gla ? gdst + ((size_t)(col >> 6) * 65536 + row * 64 + (col & 63)) : ddst + (row * T + col);
                        *(u32x2*)dst = o;
                    }
            }
    }
};
template <class FE> __device__ __forceinline__ void run_gemm(char* shm, const bf16_t* A, const bf16_t* Bt, int M, int N, int K, const FE& fe) {
    int c_ = (int)blockIdx.x; asm volatile("" : "+s"(c_));
    pg8::StaticOrder S; S.init(M, N, (int)gridDim.x, c_);
    pg8::gemm_phase<FE, pg8::StaticOrder, false>((PG8_LAS unsigned char*)shm, pg8::Gemm{A, Bt, M, N, K}, S, fe, nullptr);
}

__device__ __forceinline__ void phase_mod(const P& p, float* lds) {
    float* sc = lds; float* red = lds + 8192;
    const int t = otid();
    bool ready = false;
    for (int item = gridDim.x - 1 - blockIdx.x; item < 192; item += gridDim.x) {
        if (!ready) { for (int i = t; i < 8192; i += 512) sc[i] = siluf(p.c[i]); ready = true; __syncthreads(); }
        const int cl = t & 31, ks = t >> 5, col = item * 32 + cl;
        float acc[8];
#pragma unroll
        for (int b = 0; b < 8; ++b) acc[b] = 0.f;
#pragma unroll 8
        for (int k = ks * 64; k < ks * 64 + 64; ++k) {
            const float w = __builtin_nontemporal_load(p.w_ada + (size_t)k * 6144 + col);
#pragma unroll
            for (int b = 0; b < 8; ++b) acc[b] += sc[b * 1024 + k] * w;
        }
#pragma unroll
        for (int b = 0; b < 8; ++b) red[(ks * 8 + b) * 32 + cl] = acc[b];
        __syncthreads();
        if (t < 256) {
            const int b = t >> 5, cc = t & 31; float s = 0.f;
#pragma unroll
            for (int k2 = 0; k2 < 16; ++k2) s += red[(k2 * 8 + b) * 32 + cc];
            p.mod[b * 6144 + item * 32 + cc] = s + p.b_ada[item * 32 + cc];
        }
        __syncthreads();
    }
}
__device__ __forceinline__ void convert_one(const float* W, int ldw, int K, bf16_t* dst, int nrows, int kind, float* lds, int& rot) {
    const int ntk = K / 64, nt = (nrows / 64) * ntk, G = gridDim.x, t = otid();
    int first = (int)blockIdx.x + G - rot; if (first >= G) first -= G;
    for (int tile = first; tile < nt; tile += G) {
        const int tr = tile / ntk, k0 = (tile % ntk) * 64;
        const int pbase = (tr >> 2) * 256 + (tr & 3) * 32;
#define CONV_PROW(pp) (pbase + ((pp) >> 5) * 128 + ((pp) & 31))
        {
            const int pp = t & 63, kq = t >> 6; const int s = src_physical(kind, CONV_PROW(pp));
#pragma unroll
            for (int i = 0; i < 8; ++i) { const int kk = kq + 8 * i; lds[kk * 65 + pp] = s < 0 ? 0.f : __builtin_nontemporal_load(W + (size_t)(k0 + kk) * ldw + s); }
        }
        __syncthreads();
        {
            const int pp = t >> 3, ks = (t & 7) * 8; u32x4 o;
            o.x = pk2(lds[(ks + 0) * 65 + pp], lds[(ks + 1) * 65 + pp]); o.y = pk2(lds[(ks + 2) * 65 + pp], lds[(ks + 3) * 65 + pp]);
            o.z = pk2(lds[(ks + 4) * 65 + pp], lds[(ks + 5) * 65 + pp]); o.w = pk2(lds[(ks + 6) * 65 + pp], lds[(ks + 7) * 65 + pp]);
            *(u32x4*)(dst + (size_t)CONV_PROW(pp) * K + k0 + ks) = o;
        }
        __syncthreads();
    }
    rot += nt; while (rot >= G) rot -= G;
}
__device__ __forceinline__ void phase_convert(const P& p, float* lds) {
    int rot = 0;
    convert_one(p.w_in, NIN, 1024, p.wt_in1, 4352, 0, lds, rot);
    convert_one(p.w_in, NIN, 1024, p.wt_in2, 2048, 1, lds, rot);
    convert_one(p.w_in, NIN, 1024, p.wt_gv, 1024, 2, lds, rot);
    convert_one(p.w_in, NIN, 1024, p.wt_dv, 1024, 3, lds, rot);
    convert_one(p.w_gla_o, 1024, 1024, p.wt_glao, 1024, 4, lds, rot);
    convert_one(p.w_diff_o, 1024, 1024, p.wt_diffo, 1024, 4, lds, rot);
    convert_one(p.w_out, 1024, 1024, p.wt_out, 1024, 4, lds, rot);
    convert_one(p.w_up, 5632, 1024, p.wt_up, 5632, 5, lds, rot);
    convert_one(p.w_down, 1024, 2816, p.wt_down, 1024, 6, lds, rot);
}

__device__ __forceinline__ void phase_norm(const P& p, const float* src, const float* g, int sh_off, int sc_off, bf16_t* dst) {
    const int t_ = otid(), lane = t_ & 63, w = t_ >> 6;
    for (int vb = blockIdx.x; vb < 256; vb += gridDim.x) {
        const int b = vb >> 5;
        const float* md = p.mod + (size_t)b * 6144;
        f32x4 gs[4], sh[4];
#pragma unroll
        for (int i = 0; i < 4; ++i) {
            const int e = i * 256 + lane * 4;
            const f32x4 gg = *(const f32x4*)(g + e), sc = *(const f32x4*)(md + sc_off + e);
            gs[i] = gg * (sc + 1.f); sh[i] = *(const f32x4*)(md + sh_off + e);
        }
        for (int rr = 0; rr < 4; ++rr) {
            f32x4 xv[4][4]; float ss[4];
#pragma unroll
            for (int q = 0; q < 4; ++q) {
                const size_t row = (size_t)vb * 128 + w + 8 * (4 * rr + q);
                ss[q] = 0.f;
#pragma unroll
                for (int i = 0; i < 4; ++i) xv[q][i] = __builtin_nontemporal_load((const f32x4*)(src + row * 1024 + i * 256 + lane * 4));
            }
#pragma unroll
            for (int q = 0; q < 4; ++q) {
#pragma unroll
                for (int i = 0; i < 4; ++i) ss[q] += xv[q][i].x * xv[q][i].x + xv[q][i].y * xv[q][i].y + xv[q][i].z * xv[q][i].z + xv[q][i].w * xv[q][i].w;
#pragma unroll
                for (int o = 32; o >= 1; o >>= 1) ss[q] += __shfl_xor(ss[q], o);
            }
#pragma unroll
            for (int q = 0; q < 4; ++q) {
                const size_t row = (size_t)vb * 128 + w + 8 * (4 * rr + q);
                const float rstd = rsqrtf(ss[q] * (1.f / 1024.f) + EPS);
#pragma unroll
                for (int i = 0; i < 4; ++i) {
                    const f32x4 y = xv[q][i] * rstd * gs[i] + sh[i];
                    u32x2 o; o.x = pk2(y.x, y.y); o.y = pk2(y.z, y.w);
                    *(u32x2*)(dst + row * 1024 + i * 256 + lane * 4) = o;
                }
            }
        }
    }
}

__device__ __forceinline__ void phase_norm_b(const P& p, const bf16_t* src, const float* g, int sh_off, int sc_off, bf16_t* dst) {
    const int t_ = otid(), lane = t_ & 63, w = t_ >> 6;
    for (int vb = blockIdx.x; vb < 256; vb += gridDim.x) {
        const int b = vb >> 5;
        const float* md = p.mod + (size_t)b * 6144;
        f32x4 gs[4], sh[4];
#pragma unroll
        for (int i = 0; i < 4; ++i) {
            const int e = i * 256 + lane * 4;
            const f32x4 gg = *(const f32x4*)(g + e), sc = *(const f32x4*)(md + sc_off + e);
            gs[i] = gg * (sc + 1.f); sh[i] = *(const f32x4*)(md + sh_off + e);
        }
        for (int rr = 0; rr < 4; ++rr) {
            f32x4 xv[4][4]; float ss[4];
#pragma unroll
            for (int q = 0; q < 4; ++q) {
                const size_t row = (size_t)vb * 128 + w + 8 * (4 * rr + q);
                ss[q] = 0.f;
#pragma unroll
                for (int i = 0; i < 4; ++i) {
                    const u32x2 r = *(const u32x2*)(src + row * 1024 + i * 256 + lane * 4);
                    xv[q][i] = (f32x4){__uint_as_float(r.x << 16), __uint_as_float(r.x & 0xFFFF0000u), __uint_as_float(r.y << 16), __uint_as_float(r.y & 0xFFFF0000u)};
                }
            }
#pragma unroll
            for (int q = 0; q < 4; ++q) {
#pragma unroll
                for (int i = 0; i < 4; ++i) ss[q] += xv[q][i].x * xv[q][i].x + xv[q][i].y * xv[q][i].y + xv[q][i].z * xv[q][i].z + xv[q][i].w * xv[q][i].w;
#pragma unroll
                for (int o = 32; o >= 1; o >>= 1) ss[q] += __shfl_xor(ss[q], o);
            }
#pragma unroll
            for (int q = 0; q < 4; ++q) {
                const size_t row = (size_t)vb * 128 + w + 8 * (4 * rr + q);
                const float rstd = rsqrtf(ss[q] * (1.f / 1024.f) + EPS);
#pragma unroll
                for (int i = 0; i < 4; ++i) {
                    const f32x4 y = xv[q][i] * rstd * gs[i] + sh[i];
                    u32x2 o; o.x = pk2(y.x, y.y); o.y = pk2(y.z, y.w);
                    *(u32x2*)(dst + row * 1024 + i * 256 + lane * 4) = o;
                }
            }
        }
    }
}

__device__ __forceinline__ void phase_scan(const P& p) {
    const int t_ = otid();
    for (int task = blockIdx.x * 512 + t_; task < 32 * 4096; task += gridDim.x * 512) {
        const int bh = task >> 12, within = task & 4095, e = within >> 4, d8 = (within & 15) * 8;
        float st[8];
#pragma unroll
        for (int i = 0; i < 8; ++i) st[i] = 0.f;
        for (int n = 0; n < 64; ++n) {
            const size_t ci = (size_t)bh * 64 + n;
            bf16_t* ptr = p.delta + (ci * 256 + e) * 128 + d8;
            const u32x4 dv = *(const u32x4*)ptr;
            const f32x4 d0 = *(const f32x4*)(p.decay + ci * 128 + d8), d1 = *(const f32x4*)(p.decay + ci * 128 + d8 + 4);
            const float dec[8] = {d0.x, d0.y, d0.z, d0.w, d1.x, d1.y, d1.z, d1.w};
            const unsigned w[4] = {dv.x, dv.y, dv.z, dv.w};
            u32x4 o; o.x = pk2(st[0], st[1]); o.y = pk2(st[2], st[3]); o.z = pk2(st[4], st[5]); o.w = pk2(st[6], st[7]);
            *(u32x4*)ptr = o;
#pragma unroll
            for (int i = 0; i < 4; ++i) {
                st[2 * i] = dec[2 * i] * st[2 * i] + __uint_as_float(w[i] << 16);
                st[2 * i + 1] = dec[2 * i + 1] * st[2 * i + 1] + __uint_as_float(w[i] & 0xFFFF0000u);
            }
        }
    }
}

__device__ __forceinline__ void phase_conv(const P& p, int half) {
    const int t_ = otid();
    for (int blk = blockIdx.x; blk < 512; blk += gridDim.x) {
        for (int task = t_; task < 1408; task += 512) {
            const int run = task / 352, cgp = task % 352;
            const int t0 = blk * 64 + run * 16;
            const int chl = cgp * 4, ch = half * 1408 + chl;
            float wa[3][4], wb[3][4], ba[4], bb[4];
#pragma unroll
            for (int j = 0; j < 3; ++j)
#pragma unroll
                for (int i = 0; i < 4; ++i) { wa[j][i] = p.conv_w[j * 5632 + ch + i]; wb[j][i] = p.conv_w[j * 5632 + 2816 + ch + i]; }
#pragma unroll
            for (int i = 0; i < 4; ++i) { ba[i] = p.conv_b[ch + i]; bb[i] = p.conv_b[2816 + ch + i]; }
            float a2[4], a1[4], b2[4], b1[4];
#pragma unroll
            for (int i = 0; i < 4; ++i) { a2[i] = a1[i] = b2[i] = b1[i] = 0.f; }
            if ((t0 & 4095) != 0) {
                const u32x4 r2 = *(const u32x4*)(p.uh + (size_t)(t0 - 2) * 2816 + 2 * chl), r1 = *(const u32x4*)(p.uh + (size_t)(t0 - 1) * 2816 + 2 * chl);
                const unsigned w2[4] = {r2.x, r2.y, r2.z, r2.w}, w1[4] = {r1.x, r1.y, r1.z, r1.w};
#pragma unroll
                for (int i = 0; i < 4; ++i) { a2[i] = __uint_as_float(w2[i] << 16); b2[i] = __uint_as_float(w2[i] & 0xFFFF0000u); a1[i] = __uint_as_float(w1[i] << 16); b1[i] = __uint_as_float(w1[i] & 0xFFFF0000u); }
            }
#pragma unroll
            for (int tt = 0; tt < 16; ++tt) {
                const u32x4 r0 = *(const u32x4*)(p.uh + (size_t)(t0 + tt) * 2816 + 2 * chl);
                const unsigned w0[4] = {r0.x, r0.y, r0.z, r0.w};
                float o[4];
#pragma unroll
                for (int i = 0; i < 4; ++i) {
                    const float a0 = __uint_as_float(w0[i] << 16), b0 = __uint_as_float(w0[i] & 0xFFFF0000u);
                    const float ca = wa[0][i] * a2[i] + wa[1][i] * a1[i] + wa[2][i] * a0 + ba[i];
                    const float cb = wb[0][i] * b2[i] + wb[1][i] * b1[i] + wb[2][i] * b0 + bb[i];
                    o[i] = siluf(ca) * cb;
                    a2[i] = a1[i]; a1[i] = a0; b2[i] = b1[i]; b1[i] = b0;
                }
                u32x2 ov; ov.x = pk2(o[0], o[1]); ov.y = pk2(o[2], o[3]);
                *(u32x2*)(p.act + (size_t)(t0 + tt) * 2816 + ch) = ov;
            }
        }
    }
}

__device__ __forceinline__ void simple_bcum(const P& p, int t, int hh, size_t tok0, float* bc, float* ac, float* wup) {
    for (int i = t; i < 1024; i += 512) ac[i] = p.acode[tok0 * 16 + i];
    for (int i = t; i < 2048; i += 512) wup[i] = p.w_alpha_up[(i >> 7) * 512 + hh * 128 + (i & 127)];
    __syncthreads();
    {
        const int d = t & 127, qt = t >> 7; const float ba = p.b_alpha[hh * 128 + d];
        for (int c = qt * 16; c < qt * 16 + 16; ++c) {
            float z = ba;
#pragma unroll
            for (int r = 0; r < 16; ++r) z += ac[c * 16 + r] * wup[r * 128 + d];
            bc[c * 129 + d] = logsigf(z) * (1.f / 16.f);
        }
    }
    __syncthreads();
    if (t < 128) { float run = 0.f; for (int c = 0; c < 64; ++c) { run += bc[c * 129 + t]; bc[c * 129 + t] = run; } }
    __syncthreads();
}
__device__ __forceinline__ void simple_g1(const P& p, float* sm) {
    float* kk = sm; float* bc = kk + 64 * 129; float* ac = bc + 64 * 129; float* wup = ac + 1024;
    const int t = otid();
    for (int ci = blockIdx.x; ci < 2048; ci += gridDim.x) {
        const int bh = ci >> 6, n = ci & 63, b = bh >> 2, hh = bh & 3;
        const size_t tok0 = (size_t)b * 4096 + n * 64;
        __syncthreads();
        for (int i = t; i < 8192; i += 512) { const int c = i >> 7, d = i & 127; kk[c * 129 + d] = bf2f(p.gk[(tok0 + c) * 512 + hh * 128 + d]); }
        simple_bcum(p, t, hh, tok0, bc, ac, wup);
        for (int i = t; i < 8192; i += 512) { const int c = i >> 7, d = i & 127; kk[c * 129 + d] *= __expf(bc[63 * 129 + d] - bc[c * 129 + d]); }
        if (t < 128) p.decay[(size_t)ci * 128 + t] = __expf(bc[63 * 129 + t]);
        __syncthreads();
        const int d = t & 127;
        for (int e = t >> 7; e < 256; e += 4) {
            const bf16_t* vr = p.gvT + (size_t)(hh * 256 + e) * T + tok0;
            float s = 0.f;
            for (int c = 0; c < 64; ++c) s += bf2f(vr[c]) * kk[c * 129 + d];
            p.delta[((size_t)ci * 256 + e) * 128 + d] = f2bf(s);
        }
    }
}
__device__ __forceinline__ void simple_g3(const P& p, float* sm) {
    float* qq = sm; float* kk = qq + 64 * 129; float* bc = kk + 64 * 129; float* sc = bc + 64 * 129; float* ac = sc + 64 * 65; float* wup = ac + 1024; float* ssum = wup + 2048;
    const int t = otid();
    for (int ci = blockIdx.x; ci < 2048; ci += gridDim.x) {
        const int bh = ci >> 6, n = ci & 63, b = bh >> 2, hh = bh & 3;
        const size_t tok0 = (size_t)b * 4096 + n * 64;
        __syncthreads();
        for (int i = t; i < 8192; i += 512) {
            const int c = i >> 7, d = i & 127;
            qq[c * 129 + d] = bf2f(p.gq[(tok0 + c) * 512 + hh * 128 + d]); kk[c * 129 + d] = bf2f(p.gk[(tok0 + c) * 512 + hh * 128 + d]);
        }
        if (t < 64) ssum[t] = 0.f;
        simple_bcum(p, t, hh, tok0, bc, ac, wup);
        const float scale = 0.08838834764831845f;
        for (int i = t; i < 4096; i += 512) {
            const int c = i >> 6, s = i & 63; float a = 0.f;
            for (int d = 0; d < 128; ++d) a += qq[c * 129 + d] * kk[s * 129 + d] * __expf(-fabsf(bc[c * 129 + d] - bc[s * 129 + d]));
            sc[c * 65 + s] = a * scale;
        }
        __syncthreads();
        for (int i = t; i < 8192; i += 512) { const int c = i >> 7, d = i & 127; qq[c * 129 + d] *= scale * __expf(bc[c * 129 + d]); }
        __syncthreads();
        float* o = kk;
        {
            const int e = t & 255, ch = t >> 8;
            const bf16_t* vr = p.gvT + (size_t)(hh * 256 + e) * T + tok0;
            const bf16_t* sr = p.delta + ((size_t)ci * 256 + e) * 128;
            for (int c = ch * 32; c < ch * 32 + 32; ++c) {
                float a = 0.f;
                for (int s = 0; s < 64; ++s) a += sc[c * 65 + s] * bf2f(vr[s]);
                for (int d = 0; d < 128; ++d) a += qq[c * 129 + d] * bf2f(sr[d]);
                o[c * 256 + e] = a; atomicAdd(&ssum[c], a * a);
            }
        }
        __syncthreads();
        for (int i = t; i < 16384; i += 512) {
            const int c = i >> 8, e = i & 255;
            bf16_t* gp = p.gg + (tok0 + c) * 1024 + hh * 256 + e;
            *gp = f2bf(o[i] * rsqrtf(ssum[c] * (1.f / 256.f) + EPS) * p.gla_norm_g[e] * bf2f(*gp));
        }
    }
}

__device__ __forceinline__ float lambda_full(const P& p) {
    float s1 = 0.f, s2 = 0.f;
    for (int i = 0; i < 64; ++i) { s1 += p.lam_q1[i] * p.lam_k1[i]; s2 += p.lam_q2[i] * p.lam_k2[i]; }
    return __expf(s1) - __expf(s2) + 0.2f;
}
__device__ __forceinline__ void simple_attn(const P& p, float* sm) {
    float* qs = sm; float* ks = qs + 2 * 64 * 65; float* vs = ks + 2 * 64 * 65;
    const int t = otid(), r = t & 63, part = t >> 6, j = part & 1, eq = part >> 1;
    const float lam = lambda_full(p);
    for (int item = blockIdx.x; item < 4096; item += gridDim.x) {
        const int c = 63 - (item >> 6), bh = item & 63, b = bh >> 3, hh = bh & 7;
        const size_t tok0 = (size_t)b * 4096 + c * 64;
        __syncthreads();
        for (int i = t; i < 8192; i += 512) { const int jj = i >> 12, rr = (i >> 6) & 63, d = i & 63; qs[(jj * 64 + rr) * 65 + d] = bf2f(p.dq[(tok0 + rr) * 1024 + hh * 128 + jj * 64 + d]); }
        const float sl2 = exp2f(-(float)(hh + 1)) * LOG2E;
        float m = -INFINITY, l = 0.f, acc[32];
#pragma unroll
        for (int e = 0; e < 32; ++e) acc[e] = 0.f;
        const int qpos = c * 64 + r;
        for (int kt = 0; kt <= c; ++kt) {
            __syncthreads();
            for (int i = t; i < 8192; i += 512) { const int jj = i >> 12, ss = (i >> 6) & 63, d = i & 63; ks[(jj * 64 + ss) * 65 + d] = bf2f(p.dk[((size_t)b * 4096 + kt * 64 + ss) * 1024 + hh * 128 + jj * 64 + d]); }
            for (int i = t; i < 8192; i += 512) { const int ss = i & 63, e = i >> 6; vs[ss * 128 + e] = bf2f(p.dvT[(size_t)(hh * 128 + e) * T + (size_t)b * 4096 + kt * 64 + ss]); }
            __syncthreads();
            for (int s = 0; s < 64; ++s) {
                float dot = 0.f;
#pragma unroll
                for (int d = 0; d < 64; ++d) dot += qs[(j * 64 + r) * 65 + d] * ks[(j * 64 + s) * 65 + d];
                const int kpos = kt * 64 + s;
                const float lg = dot - sl2 * fabsf((float)(qpos - kpos));
                if (lg > m) {
                    const float a = exp2f(m - lg); l *= a;
#pragma unroll
                    for (int e = 0; e < 32; ++e) acc[e] *= a;
                    m = lg;
                }
                const float pp = exp2f(lg - m); l += pp;
#pragma unroll
                for (int e = 0; e < 32; ++e) acc[e] += pp * vs[s * 128 + eq * 32 + e];
            }
        }
        __syncthreads();
        float* buf = ks; float* ssum = qs;
        const float inv = 1.f / l;
        if (j == 1) {
#pragma unroll
            for (int e = 0; e < 32; ++e) buf[r * 128 + eq * 32 + e] = lam * acc[e] * inv;
        }
        if (t < 64) ssum[t] = 0.f;
        __syncthreads();
        if (j == 0) {
            float ss = 0.f;
#pragma unroll
            for (int e = 0; e < 32; ++e) { acc[e] = acc[e] * inv - buf[r * 128 + eq * 32 + e]; ss += acc[e] * acc[e]; }
            atomicAdd(&ssum[r], ss);
        }
        __syncthreads();
        if (j == 0) {
            const float rstd = rsqrtf(ssum[r] * (1.f / 128.f) + EPS) * 0.8f;
            bf16_t* dst = p.dq + (tok0 + r) * 1024 + hh * 128 + eq * 32;
#pragma unroll
            for (int e = 0; e < 32; ++e) dst[e] = f2bf(acc[e] * rstd * p.diff_norm_g[eq * 32 + e]);
        }
    }
}

typedef short bf16x8 __attribute__((ext_vector_type(8)));
typedef float f32x16 __attribute__((ext_vector_type(16)));
__device__ __forceinline__ unsigned cvtpk(float lo, float hi) { return pk2(lo, hi); }
__device__ __forceinline__ void attn_phase(const P& p, char* smem) {
    constexpr int KBYTES = 64 * 272, VBYTES = 128 * 144, TBYTES = KBYTES + VBYTES;
    const int t = otid(), lane = t & 63, w = t >> 6, j = w & 1, g = w >> 1, lq = lane & 31, h = lane >> 5;
    const float lam = lambda_full(p);
    float gqm = 0.f, gkm = 0.f;
    for (int i = 0; i < 64; ++i) { gqm = fmaxf(gqm, fabsf(p.q_norm_g[i])); gkm = fmaxf(gkm, fabsf(p.k_norm_g[i])); }
    const float thr = 2.f * (64.f * 0.125f * LOG2E * gqm * gkm * 1.03f) + 152.f;
    int* qslot = (int*)(smem + 2 * TBYTES);
    if (t == 0) qslot[0] = (int)atomicAdd(p.ctr, 1u);
    __syncthreads();
    int idx = qslot[0], par = 0;
    while (idx < 2048) {
        int nxt_item = 0;
        if (t == 0) nxt_item = (int)atomicAdd(p.ctr, 1u);
        const int qb = 31 - (idx >> 6), bh = idx & 63, b = bh >> 3, hh = bh & 7;
        const int q0 = qb * 128;
        const size_t tokq = (size_t)b * 4096 + q0 + 32 * g + lq;
        bf16x8 qf[4];
#pragma unroll
        for (int ks = 0; ks < 4; ++ks) qf[ks] = *(const bf16x8*)(p.dq + tokq * 1024 + hh * 128 + j * 64 + ks * 16 + h * 8);
        const int cw = 2 * qb + (g >> 1), ktmax = 2 * qb + 1;
        const float sl2 = exp2f(-(float)(hh + 1)) * LOG2E;
        const int xk = q0 - 63 - (int)ceilf(thr / sl2);
        const int ktmin = xk <= 0 ? 0 : (xk + 63) >> 6;
        f32x16 cinit;
#pragma unroll
        for (int r = 0; r < 16; ++r) cinit[r] = sl2 * (float)((r & 3) + 8 * (r >> 2));
        f32x16 O[4];
#pragma unroll
        for (int eb = 0; eb < 4; ++eb)
#pragma unroll
            for (int r = 0; r < 16; ++r) O[eb][r] = 0.f;
        float m = -INFINITY, l = 0.f;
        const bf16_t* kbase = p.dk + (size_t)b * 4096 * 1024 + hh * 128; const bf16_t* vbase = p.dvT + (size_t)hh * 128 * T + (size_t)b * 4096;
        int ksrc[2], vsrc[2], kdst[2], vdst[2];
#pragma unroll
        for (int i = 0; i < 2; ++i) {
            const int ck = t + 512 * i;
            { const int row = ck >> 4, cc = ck & 15; ksrc[i] = row * 1024 + cc * 8; kdst[i] = row * 272 + cc * 16; }
            { const int e = ck >> 3, cc = ck & 7; vsrc[i] = e * T + cc * 8; vdst[i] = KBYTES + e * 144 + (cc >> 1) * 32 + (cc & 1) * 8; }
        }
        {
            u32x4 kr[2], vr[2];
#pragma unroll
            for (int i = 0; i < 2; ++i) { kr[i] = *(const u32x4*)(kbase + (size_t)ktmax * 64 * 1024 + ksrc[i]); vr[i] = *(const u32x4*)(vbase + ktmax * 64 + vsrc[i]); }
#pragma unroll
            for (int i = 0; i < 2; ++i) {
                *(u32x4*)(smem + kdst[i]) = kr[i];
                *(u32x2*)(smem + vdst[i]) = (u32x2){vr[i].x, vr[i].y}; *(u32x2*)(smem + vdst[i] + 16) = (u32x2){vr[i].z, vr[i].w};
            }
        }
        __syncthreads();
        int cur = 0;
        for (int kt = ktmax; kt >= ktmin; --kt) {
            u32x4 kr[2], vr[2];
            if (kt > ktmin) {
#pragma unroll
                for (int i = 0; i < 2; ++i) { kr[i] = *(const u32x4*)(kbase + (size_t)(kt - 1) * 64 * 1024 + ksrc[i]); vr[i] = *(const u32x4*)(vbase + (kt - 1) * 64 + vsrc[i]); }
            }
            if (kt <= cw) {
                const char* Kb = smem + cur * TBYTES; const char* Vb = Kb + KBYTES;
                f32x16 S[2];
#pragma unroll
                for (int kb = 0; kb < 2; ++kb) {
                    S[kb] = cinit;
#pragma unroll
                    for (int ks = 0; ks < 4; ++ks) {
                        const bf16x8 a = *(const bf16x8*)(Kb + (kb * 32 + lq) * 272 + j * 128 + ks * 32 + h * 16);
                        S[kb] = __builtin_amdgcn_mfma_f32_32x32x16_bf16(a, qf[ks], S[kb], 0, 0, 0);
                    }
                }
                if (kt == cw) {
                    int qi = 32 * (g & 1) + lq; asm volatile("" : "+v"(qi));
#pragma unroll
                    for (int kb = 0; kb < 2; ++kb)
#pragma unroll
                        for (int r = 0; r < 16; ++r) {
                            const int keyi = kb * 32 + (r & 3) + 8 * (r >> 2) + 4 * h;
                            S[kb][r] += 2.f * sl2 * fminf((float)(qi - keyi), 0.f);
                        }
                }
                const float base0 = sl2 * (float)(kt * 64 + 4 * h - q0), base1 = base0 + sl2 * 32.f;
                float mx0 = S[0][0], mx1 = S[1][0];
#pragma unroll
                for (int r = 1; r < 16; ++r) { mx0 = fmaxf(mx0, S[0][r]); mx1 = fmaxf(mx1, S[1][r]); }
                float mloc = fmaxf(mx0 + base0, mx1 + base1);
                mloc = fmaxf(mloc, __shfl_xor(mloc, 32));
                const float mnew = fmaxf(m, mloc);
                if (__any(mnew > m)) {
                    const float alpha = __builtin_amdgcn_exp2f(m - mnew);
                    l *= alpha;
#pragma unroll
                    for (int eb = 0; eb < 4; ++eb)
#pragma unroll
                        for (int r = 0; r < 16; ++r) O[eb][r] *= alpha;
                }
                m = mnew;
                const float off0 = base0 - m, off1 = base1 - m;
                float ls = 0.f;
#pragma unroll
                for (int r = 0; r < 16; ++r) { S[0][r] = __builtin_amdgcn_exp2f(S[0][r] + off0); S[1][r] = __builtin_amdgcn_exp2f(S[1][r] + off1); ls += S[0][r] + S[1][r]; }
                l += ls;
                bf16x8 pf[4];
#pragma unroll
                for (int kk = 0; kk < 4; ++kk) {
                    const int kb = kk >> 1, s8 = (kk & 1) * 8;
                    u32x4 pk; pk.x = cvtpk(S[kb][s8 + 0], S[kb][s8 + 1]); pk.y = cvtpk(S[kb][s8 + 2], S[kb][s8 + 3]); pk.z = cvtpk(S[kb][s8 + 4], S[kb][s8 + 5]); pk.w = cvtpk(S[kb][s8 + 6], S[kb][s8 + 7]);
                    pf[kk] = __builtin_bit_cast(bf16x8, pk);
                }
#pragma unroll
                for (int eb = 0; eb < 4; ++eb)
#pragma unroll
                    for (int kk = 0; kk < 4; ++kk) {
                        const bf16x8 a = *(const bf16x8*)(Vb + (eb * 32 + lq) * 144 + kk * 32 + h * 16);
                        O[eb] = __builtin_amdgcn_mfma_f32_32x32x16_bf16(a, pf[kk], O[eb], 0, 0, 0);
                    }
            }
            if (kt > ktmin) {
                char* nb = smem + (cur ^ 1) * TBYTES;
#pragma unroll
                for (int i = 0; i < 2; ++i) {
                    *(u32x4*)(nb + kdst[i]) = kr[i];
                    *(u32x2*)(nb + vdst[i]) = (u32x2){vr[i].x, vr[i].y}; *(u32x2*)(nb + vdst[i] + 16) = (u32x2){vr[i].z, vr[i].w};
                }
            }
            __syncthreads();
            cur ^= 1;
        }
        l += __shfl_xor(l, 32);
        const float inv = 1.f / l;
        float* ob = (float*)smem;
        if (j == 1) {
            const float sc = lam * inv;
#pragma unroll
            for (int eb = 0; eb < 4; ++eb)
#pragma unroll
                for (int r = 0; r < 16; ++r) { const int e = eb * 32 + (r & 3) + 8 * (r >> 2) + 4 * h; ob[(g * 128 + e) * 32 + lq] = O[eb][r] * sc; }
        }
        __syncthreads();
        if (j == 0) {
            float ss = 0.f;
#pragma unroll
            for (int eb = 0; eb < 4; ++eb)
#pragma unroll
                for (int r = 0; r < 16; ++r) { const int e = eb * 32 + (r & 3) + 8 * (r >> 2) + 4 * h; const float o = O[eb][r] * inv - ob[(g * 128 + e) * 32 + lq]; O[eb][r] = o; ss += o * o; }
            ss += __shfl_xor(ss, 32);
            const float rstd = rsqrtf(ss * (1.f / 128.f) + EPS) * 0.8f;
            bf16_t* dst = p.h + tokq * 1024 + hh * 128;
#pragma unroll
            for (int eb = 0; eb < 4; ++eb)
#pragma unroll
                for (int i = 0; i < 4; ++i) {
                    const int e0 = eb * 32 + 8 * i + 4 * h;
                    const f32x4 gv = *(const f32x4*)(p.diff_norm_g + e0);
                    u32x2 o; o.x = pk2(O[eb][4 * i] * rstd * gv.x, O[eb][4 * i + 1] * rstd * gv.y); o.y = pk2(O[eb][4 * i + 2] * rstd * gv.z, O[eb][4 * i + 3] * rstd * gv.w);
                    *(u32x2*)(dst + e0) = o;
                }
        }
        if (t == 0) qslot[par ^ 1] = nxt_item;
        __syncthreads();
        idx = qslot[par ^ 1]; par ^= 1;
    }
}

template <int CTRL, int ROWMASK> __device__ __forceinline__ float dpp_add(float x) {
    return x + __builtin_bit_cast(float, __builtin_amdgcn_update_dpp(0, __builtin_bit_cast(int, x), CTRL, ROWMASK, 0xf, false));
}
__device__ __forceinline__ float wave_incl_scan(float x) {
    x = dpp_add<0x111, 0xf>(x); x = dpp_add<0x112, 0xf>(x); x = dpp_add<0x114, 0xf>(x); x = dpp_add<0x118, 0xf>(x);
    x = dpp_add<0x142, 0xa>(x); x = dpp_add<0x143, 0xc>(x);
    return x;
}
__device__ __forceinline__ void gla_load_ac(const P& p, size_t tok0, int lane, float (&ac)[16]) {
#pragma unroll
    for (int i = 0; i < 4; ++i) { const f32x4 v = *(const f32x4*)(p.acode + (tok0 + lane) * 16 + 4 * i); ac[4 * i] = v.x; ac[4 * i + 1] = v.y; ac[4 * i + 2] = v.z; ac[4 * i + 3] = v.w; }
}
__device__ __forceinline__ void gla_gate4(const float* wl, int d0, int lane, const float (&ac)[16], float (&B4)[4]) {
    f32x4 z = *(const f32x4*)(wl + 8192 + d0);
#pragma unroll
    for (int r = 0; r < 16; ++r) { const f32x4 wv = *(const f32x4*)(wl + r * 512 + d0); z.x += ac[r] * wv.x; z.y += ac[r] * wv.y; z.z += ac[r] * wv.z; z.w += ac[r] * wv.w; }
    const float zz[4] = {z.x, z.y, z.z, z.w};
#pragma unroll
    for (int i = 0; i < 4; ++i) B4[i] = wave_incl_scan(logsigf(zz[i]) * (1.f / 16.f));
}
__device__ __forceinline__ void gla_stage_w(const P& p, float* wl, int t) {
    for (int i = t; i < 8192; i += 512) wl[i] = p.w_alpha_up[i];
    wl[8192 + t] = p.b_alpha[t];
}
__device__ __forceinline__ void ldbf16x16(const bf16_t* src, float (&v)[16]) { ld16_bf16(src, v); }
__device__ __forceinline__ void g1_phase(const P& p, char* smem) {
    char* KD = smem;
    const int t = otid(), lane = t & 63, w = __builtin_amdgcn_readfirstlane(t >> 6), lq = lane & 31, h = lane >> 5;
    float* wl = (float*)(smem + 20480); gla_stage_w(p, wl, t);
    for (int ci = blockIdx.x; ci < 2048; ci += gridDim.x) {
        const int bh = ci >> 6, n = ci & 63, b = bh >> 2, hh = bh & 3;
        const size_t tok0 = (size_t)b * 4096 + n * 64;
        __syncthreads();
        bf16x8 bV[4];
#pragma unroll
        for (int ks = 0; ks < 4; ++ks) bV[ks] = *(const bf16x8*)(p.gvT + (tok0 >> 6) * 65536 + (size_t)(hh * 256 + 32 * w + lq) * 64 + ks * 16 + h * 8);
        {
            float ac[16]; gla_load_ac(p, tok0, lane, ac);
            const bf16_t* kp = p.gk + (tok0 + lane) * 512 + hh * 128 + 16 * w;
            const u32x4 kA = *(const u32x4*)kp, kB = *(const u32x4*)(kp + 8);
#pragma unroll 1
            for (int grp = 0; grp < 4; ++grp) {
                const int dl = 16 * w + 4 * grp;
                u32x2 kr; kr.x = grp == 0 ? kA.x : grp == 1 ? kA.z : grp == 2 ? kB.x : kB.z; kr.y = grp == 0 ? kA.y : grp == 1 ? kA.w : grp == 2 ? kB.y : kB.w;
                float B4[4]; gla_gate4(wl, hh * 128 + dl, lane, ac, B4);
                const float kv[4] = {__uint_as_float(kr.x << 16), __uint_as_float(kr.x & 0xFFFF0000u), __uint_as_float(kr.y << 16), __uint_as_float(kr.y & 0xFFFF0000u)};
#pragma unroll
                for (int i = 0; i < 4; ++i) {
                    const float Bl = __shfl(B4[i], 63);
                    *(bf16_t*)(KD + (dl + i) * 144 + lane * 2) = f2bf(kv[i] * __expf(Bl - B4[i]));
                    if (lane == 63) p.decay[(size_t)ci * 128 + dl + i] = __expf(B4[i]);
                }
            }
        }
        __syncthreads();
        bf16_t* drow = p.delta + ((size_t)ci * 256 + 32 * w + lq) * 128;
#pragma unroll
        for (int db = 0; db < 4; ++db) {
            f32x16 acc;
#pragma unroll
            for (int r = 0; r < 16; ++r) acc[r] = 0.f;
#pragma unroll
            for (int ks = 0; ks < 4; ++ks) {
                const bf16x8 a = *(const bf16x8*)(KD + (db * 32 + lq) * 144 + ks * 32 + h * 16);
                acc = __builtin_amdgcn_mfma_f32_32x32x16_bf16(a, bV[ks], acc, 0, 0, 0);
            }
#pragma unroll
            for (int i = 0; i < 4; ++i) {
                u32x2 o; o.x = pk2(acc[4 * i], acc[4 * i + 1]); o.y = pk2(acc[4 * i + 2], acc[4 * i + 3]);
                *(u32x2*)(drow + db * 32 + 8 * i + 4 * h) = o;
            }
        }
    }
}
__device__ __forceinline__ void g3_phase(const P& p, char* smem) {
    constexpr int AB = 64 * 272;
    char* QF = smem; char* KF = smem + AB; char* QB = smem + 2 * AB; char* KBW = smem + 3 * AB; char* SC = smem + 4 * AB; float* ssum = (float*)(smem + 4 * AB + 64 * 144);
    const int t = otid(), lane = t & 63, w = __builtin_amdgcn_readfirstlane(t >> 6), lq = lane & 31, h = lane >> 5;
    const float scale = 0.08838834764831845f;
    float* wl = (float*)(smem + 81920); gla_stage_w(p, wl, t);
    for (int ci = blockIdx.x; ci < 2048; ci += gridDim.x) {
        const int bh = ci >> 6, n = ci & 63, b = bh >> 2, hh = bh & 3;
        const size_t tok0 = (size_t)b * 4096 + n * 64;
        __syncthreads();
        if (t < 64) ssum[t] = 0.f;
        bf16x8 aV[4], aS[8];
#pragma unroll
        for (int ks = 0; ks < 4; ++ks) aV[ks] = *(const bf16x8*)(p.gvT + (tok0 >> 6) * 65536 + (size_t)(hh * 256 + 32 * w + lq) * 64 + ks * 16 + h * 8);
#pragma unroll
        for (int ks = 0; ks < 8; ++ks) aS[ks] = *(const bf16x8*)(p.delta + ((size_t)ci * 256 + 32 * w + lq) * 128 + ks * 16 + h * 8);
        {
            float ac[16]; gla_load_ac(p, tok0, lane, ac);
            const bf16_t* qp = p.gq + (tok0 + lane) * 512 + hh * 128 + 16 * w; const bf16_t* kp = p.gk + (tok0 + lane) * 512 + hh * 128 + 16 * w;
            const u32x4 qA = *(const u32x4*)qp, qB = *(const u32x4*)(qp + 8), kA = *(const u32x4*)kp, kB = *(const u32x4*)(kp + 8);
#pragma unroll 1
            for (int grp = 0; grp < 4; ++grp) {
                const int dl = 16 * w + 4 * grp;
                u32x2 qr, kr;
                qr.x = grp == 0 ? qA.x : grp == 1 ? qA.z : grp == 2 ? qB.x : qB.z; qr.y = grp == 0 ? qA.y : grp == 1 ? qA.w : grp == 2 ? qB.y : qB.w;
                kr.x = grp == 0 ? kA.x : grp == 1 ? kA.z : grp == 2 ? kB.x : kB.z; kr.y = grp == 0 ? kA.y : grp == 1 ? kA.w : grp == 2 ? kB.y : kB.w;
                float B4[4]; gla_gate4(wl, hh * 128 + dl, lane, ac, B4);
                const float qv[4] = {__uint_as_float(qr.x << 16), __uint_as_float(qr.x & 0xFFFF0000u), __uint_as_float(qr.y << 16), __uint_as_float(qr.y & 0xFFFF0000u)};
                const float kv[4] = {__uint_as_float(kr.x << 16), __uint_as_float(kr.x & 0xFFFF0000u), __uint_as_float(kr.y << 16), __uint_as_float(kr.y & 0xFFFF0000u)};
                float a0[4], a1[4], a2[4], a3[4];
#pragma unroll
                for (int i = 0; i < 4; ++i) {
                    const float eB = __expf(B4[i]), emB = __expf(-B4[i]), qs = qv[i] * scale;
                    a0[i] = qs * eB; a1[i] = kv[i] * emB; a2[i] = qs * emB; a3[i] = kv[i] * eB;
                }
                const int off = lane * 272 + 2 * dl;
                *(u32x2*)(QF + off) = (u32x2){pk2(a0[0], a0[1]), pk2(a0[2], a0[3])}; *(u32x2*)(KF + off) = (u32x2){pk2(a1[0], a1[1]), pk2(a1[2], a1[3])};
                *(u32x2*)(QB + off) = (u32x2){pk2(a2[0], a2[1]), pk2(a2[2], a2[3])}; *(u32x2*)(KBW + off) = (u32x2){pk2(a3[0], a3[1]), pk2(a3[2], a3[3])};
            }
        }
        __syncthreads();
        {
            const int var = w >> 2, sb = w & 1, cb = (w >> 1) & 1;
            const char* Ab = (var ? KBW : KF) + (sb * 32 + lq) * 272 + h * 16; const char* Bb = (var ? QB : QF) + (cb * 32 + lq) * 272 + h * 16;
            f32x16 acc;
#pragma unroll
            for (int r = 0; r < 16; ++r) acc[r] = 0.f;
#pragma unroll
            for (int ks = 0; ks < 8; ++ks) acc = __builtin_amdgcn_mfma_f32_32x32x16_bf16(*(const bf16x8*)(Ab + ks * 32), *(const bf16x8*)(Bb + ks * 32), acc, 0, 0, 0);
            const int c = cb * 32 + lq;
#pragma unroll
            for (int r = 0; r < 16; ++r) {
                const int sidx = sb * 32 + (r & 3) + 8 * (r >> 2) + 4 * h;
                const bool keep = var ? (sidx > c) : (sidx <= c);
                if (keep) *(bf16_t*)(SC + c * 144 + sidx * 2) = f2bf(acc[r]);
            }
        }
        __syncthreads();
        u32x2 ggr[2][4];
#pragma unroll
        for (int cb = 0; cb < 2; ++cb)
#pragma unroll
            for (int i = 0; i < 4; ++i) ggr[cb][i] = *(const u32x2*)(p.gg + (tok0 + cb * 32 + lq) * 1024 + hh * 256 + 32 * w + 8 * i + 4 * h);
        f32x16 o[2];
#pragma unroll
        for (int cb = 0; cb < 2; ++cb) {
#pragma unroll
            for (int r = 0; r < 16; ++r) o[cb][r] = 0.f;
#pragma unroll
            for (int ks = 0; ks < 4; ++ks) o[cb] = __builtin_amdgcn_mfma_f32_32x32x16_bf16(aV[ks], *(const bf16x8*)(SC + (cb * 32 + lq) * 144 + ks * 32 + h * 16), o[cb], 0, 0, 0);
#pragma unroll
            for (int ks = 0; ks < 8; ++ks) o[cb] = __builtin_amdgcn_mfma_f32_32x32x16_bf16(aS[ks], *(const bf16x8*)(QF + (cb * 32 + lq) * 272 + ks * 32 + h * 16), o[cb], 0, 0, 0);
            float ss = 0.f;
#pragma unroll
            for (int r = 0; r < 16; ++r) ss += o[cb][r] * o[cb][r];
            ss += __shfl_xor(ss, 32);
            if (h == 0) atomicAdd(&ssum[cb * 32 + lq], ss);
        }
        __syncthreads();
#pragma unroll
        for (int cb = 0; cb < 2; ++cb) {
            const int c = cb * 32 + lq;
            const float rstd = rsqrtf(ssum[c] * (1.f / 256.f) + EPS);
            bf16_t* gp = p.gg + (tok0 + c) * 1024 + hh * 256;
#pragma unroll
            for (int i = 0; i < 4; ++i) {
                const int e0 = 32 * w + 8 * i + 4 * h;
                const u32x2 gr = ggr[cb][i];
                const f32x4 ng = *(const f32x4*)(p.gla_norm_g + e0);
                u32x2 ov;
                ov.x = pk2(o[cb][4 * i] * rstd * ng.x * __uint_as_float(gr.x << 16), o[cb][4 * i + 1] * rstd * ng.y * __uint_as_float(gr.x & 0xFFFF0000u));
                ov.y = pk2(o[cb][4 * i + 2] * rstd * ng.z * __uint_as_float(gr.y << 16), o[cb][4 * i + 3] * rstd * ng.w * __uint_as_float(gr.y & 0xFFFF0000u));
                *(u32x2*)(gp + e0) = ov;
            }
        }
    }
}

__device__ __forceinline__ void lds_barrier() { asm volatile("s_waitcnt lgkmcnt(0)" ::: "memory"); __builtin_amdgcn_s_barrier(); asm volatile("" ::: "memory"); }
__device__ __forceinline__ const bf16_t* kdt_ptr(const P& p, int bh, int n) { return (n < 24 ? p.kdtA : p.kdtB) + (size_t)(bh * 24 + (n < 24 ? n : n - 24)) * 8192; }
__device__ __forceinline__ void gla_prepass(const P& p, char* smem) {
    char* KD = smem;
    const int t = otid(), lane = t & 63, w = __builtin_amdgcn_readfirstlane(t >> 6);
    float* wl = (float*)(smem + 20480); gla_stage_w(p, wl, t);
    for (int item = blockIdx.x; item < 32 * 48; item += gridDim.x) {
        const int bh = item / 48, n = item % 48, b = bh >> 2, hh = bh & 3;
        const size_t tok0 = (size_t)b * 4096 + n * 64;
        __syncthreads();
        {
            float ac[16]; gla_load_ac(p, tok0, lane, ac);
            const bf16_t* kp = p.gk + (tok0 + lane) * 512 + hh * 128 + 16 * w;
            const u32x4 kA = *(const u32x4*)kp, kB = *(const u32x4*)(kp + 8);
#pragma unroll 1
            for (int grp = 0; grp < 4; ++grp) {
                const int dl = 16 * w + 4 * grp;
                u32x2 kr; kr.x = grp == 0 ? kA.x : grp == 1 ? kA.z : grp == 2 ? kB.x : kB.z; kr.y = grp == 0 ? kA.y : grp == 1 ? kA.w : grp == 2 ? kB.y : kB.w;
                float B4[4]; gla_gate4(wl, hh * 128 + dl, lane, ac, B4);
                const float kv[4] = {__uint_as_float(kr.x << 16), __uint_as_float(kr.x & 0xFFFF0000u), __uint_as_float(kr.y << 16), __uint_as_float(kr.y & 0xFFFF0000u)};
#pragma unroll
                for (int i = 0; i < 4; ++i) {
                    const float Bl = __builtin_bit_cast(float, __builtin_amdgcn_readlane(__builtin_bit_cast(int, B4[i]), 63));
                    *(bf16_t*)(KD + (dl + i) * 144 + lane * 2) = f2bf(kv[i] * __expf(Bl - B4[i]));
                    if (lane == 63) p.decg[(size_t)(bh * 48 + n) * 128 + dl + i] = __expf(B4[i]);
                }
            }
        }
        __syncthreads();
        {
            const int row = t >> 2, sg = t & 3;
            bf16_t* dst = (bf16_t*)kdt_ptr(p, bh, n) + row * 64 + sg * 16;
            const char* src = KD + row * 144 + sg * 32;
            *(u32x4*)dst = *(const u32x4*)src; *(u32x4*)(dst + 8) = *(const u32x4*)(src + 16);
        }
    }
}

__device__ __forceinline__ void gla_seq(const P& p, char* smem, int bh, int part) {
    constexpr int NPART = 4, CPP = 64 / NPART;
    constexpr int AB = 64 * 272;
    char* QF = smem; char* KF = smem + AB; char* QB = smem + 2 * AB; char* KBW = smem + 3 * AB; char* SC = smem + 4 * AB;
    char* KD0 = smem + 78848; char* KD1 = smem + 133120;
    float* ssum = (float*)(smem + 97280);
    float* dec0 = (float*)(smem + 97536); float* dec1 = (float*)(smem + 151552);
    float* wl = (float*)(smem + 98304);
    const int t = otid(), lane = t & 63, w = __builtin_amdgcn_readfirstlane(t >> 6), lq = lane & 31, h = lane >> 5;
    const float scale = 0.08838834764831845f;
    gla_stage_w(p, wl, t);
    const int b = bh >> 2, hh = bh & 3;
    f32x16 st[4];
#pragma unroll
    for (int db = 0; db < 4; ++db)
#pragma unroll
        for (int r = 0; r < 16; ++r) st[db][r] = 0.f;
    f32x4 acn[4]; u32x4 kAn, kBn;
#define GLA_LOAD_OPS(TOK) do { const size_t tk_ = (TOK); \
        _Pragma("unroll") for (int i = 0; i < 4; ++i) acn[i] = *(const f32x4*)(p.acode + (tk_ + lane) * 16 + 4 * i); \
        { const bf16_t* kp_ = p.gk + (tk_ + lane) * 512 + hh * 128 + 16 * w; \
          kAn = *(const u32x4*)kp_; kBn = *(const u32x4*)(kp_ + 8); } } while (0)
    const int nend = (part + 1) * CPP;
    for (int n = 0; n < nend; ++n) {
        const bool full = n >= part * CPP;
        const size_t tok0 = (size_t)b * 4096 + n * 64;
        if (!full) {
            const bf16_t* kd = kdt_ptr(p, bh, n); const float* dg = p.decg + (size_t)(bh * 48 + n) * 128;
            bf16x8 vR[4];
#pragma unroll
            for (int ks = 0; ks < 4; ++ks) vR[ks] = *(const bf16x8*)(p.gvT + (tok0 >> 6) * 65536 + (size_t)(hh * 256 + 32 * w + lq) * 64 + ks * 16 + h * 8);
#pragma unroll
            for (int db = 0; db < 4; ++db) {
                bf16x8 ak[4];
#pragma unroll
                for (int ks = 0; ks < 4; ++ks) ak[ks] = *(const bf16x8*)(kd + (db * 32 + lq) * 64 + ks * 16 + h * 8);
#pragma unroll
                for (int i = 0; i < 4; ++i) { const f32x4 dv = *(const f32x4*)(dg + db * 32 + 8 * i + 4 * h); st[db][4 * i] *= dv.x; st[db][4 * i + 1] *= dv.y; st[db][4 * i + 2] *= dv.z; st[db][4 * i + 3] *= dv.w; }
#pragma unroll
                for (int ks = 0; ks < 4; ++ks) st[db] = __builtin_amdgcn_mfma_f32_32x32x16_bf16(ak[ks], vR[ks], st[db], 0, 0, 0);
            }
            continue;
        }
        char* KD = KD0; float* dec = dec0;
        __syncthreads();
        if (t < 64) ssum[t] = 0.f;
        bf16x8 vT[4]; u32x2 ggr[2][4]; float ac[16];
        GLA_LOAD_OPS(tok0);
        const u32x4 kA = kAn, kB = kBn;
        u32x4 qA = {0u, 0u, 0u, 0u}, qB = {0u, 0u, 0u, 0u};
        if (full) { const bf16_t* qp_ = p.gq + (tok0 + lane) * 512 + hh * 128 + 16 * w; qA = *(const u32x4*)qp_; qB = *(const u32x4*)(qp_ + 8); }
#pragma unroll
        for (int i = 0; i < 4; ++i) { ac[4 * i] = acn[i].x; ac[4 * i + 1] = acn[i].y; ac[4 * i + 2] = acn[i].z; ac[4 * i + 3] = acn[i].w; }
#pragma unroll
        for (int ks = 0; ks < 4; ++ks) vT[ks] = *(const bf16x8*)(p.gvT + (tok0 >> 6) * 65536 + (size_t)(hh * 256 + 32 * w + lq) * 64 + ks * 16 + h * 8);
        if (full) {
#pragma unroll
            for (int cb = 0; cb < 2; ++cb)
#pragma unroll
                for (int i = 0; i < 4; ++i) ggr[cb][i] = *(const u32x2*)(p.gg + (tok0 + cb * 32 + lq) * 1024 + hh * 256 + 32 * w + 8 * i + 4 * h);
        }
        {
#pragma unroll 1
            for (int grp = 0; grp < 4; ++grp) {
                const int dl = 16 * w + 4 * grp;
                u32x2 qr, kr;
                qr.x = grp == 0 ? qA.x : grp == 1 ? qA.z : grp == 2 ? qB.x : qB.z; qr.y = grp == 0 ? qA.y : grp == 1 ? qA.w : grp == 2 ? qB.y : qB.w;
                kr.x = grp == 0 ? kA.x : grp == 1 ? kA.z : grp == 2 ? kB.x : kB.z; kr.y = grp == 0 ? kA.y : grp == 1 ? kA.w : grp == 2 ? kB.y : kB.w;
                float B4[4]; gla_gate4(wl, hh * 128 + dl, lane, ac, B4);
                const float qv[4] = {__uint_as_float(qr.x << 16), __uint_as_float(qr.x & 0xFFFF0000u), __uint_as_float(qr.y << 16), __uint_as_float(qr.y & 0xFFFF0000u)};
                const float kv[4] = {__uint_as_float(kr.x << 16), __uint_as_float(kr.x & 0xFFFF0000u), __uint_as_float(kr.y << 16), __uint_as_float(kr.y & 0xFFFF0000u)};
                float a0[4], a1[4], a2[4], a3[4];
#pragma unroll
                for (int i = 0; i < 4; ++i) {
                    const float eB = __expf(B4[i]), emB = __expf(-B4[i]), qs = qv[i] * scale;
                    a0[i] = qs * eB; a1[i] = kv[i] * emB; a2[i] = qs * emB; a3[i] = kv[i] * eB;
                    const float Bl = __builtin_bit_cast(float, __builtin_amdgcn_readlane(__builtin_bit_cast(int, B4[i]), 63));
                    *(bf16_t*)(KD + (dl + i) * 144 + lane * 2) = f2bf(kv[i] * emB * __expf(Bl));
                    if (lane == 63) dec[dl + i] = eB;
                }
                if (full) {
                    const int off = lane * 272 + 2 * dl;
                    *(u32x2*)(QF + off) = (u32x2){pk2(a0[0], a0[1]), pk2(a0[2], a0[3])}; *(u32x2*)(KF + off) = (u32x2){pk2(a1[0], a1[1]), pk2(a1[2], a1[3])};
                    *(u32x2*)(QB + off) = (u32x2){pk2(a2[0], a2[1]), pk2(a2[2], a2[3])}; *(u32x2*)(KBW + off) = (u32x2){pk2(a3[0], a3[1]), pk2(a3[2], a3[3])};
                }
            }
        }
        __syncthreads();
        f32x16 o[2];
        if (full) {
        {
            const int var = w >> 2, sb = w & 1, cb = (w >> 1) & 1;
            const char* Ab = (var ? KBW : KF) + (sb * 32 + lq) * 272 + h * 16; const char* Bb = (var ? QB : QF) + (cb * 32 + lq) * 272 + h * 16;
            f32x16 acc;
#pragma unroll
            for (int r = 0; r < 16; ++r) acc[r] = 0.f;
#pragma unroll
            for (int ks = 0; ks < 8; ++ks) acc = __builtin_amdgcn_mfma_f32_32x32x16_bf16(*(const bf16x8*)(Ab + ks * 32), *(const bf16x8*)(Bb + ks * 32), acc, 0, 0, 0);
            const int c = cb * 32 + lq;
#pragma unroll
            for (int r = 0; r < 16; ++r) {
                const int sidx = sb * 32 + (r & 3) + 8 * (r >> 2) + 4 * h;
                const bool keep = var ? (sidx > c) : (sidx <= c);
                if (keep) *(bf16_t*)(SC + c * 144 + sidx * 2) = f2bf(acc[r]);
            }
        }
        __syncthreads();
#pragma unroll
        for (int cb = 0; cb < 2; ++cb)
#pragma unroll
            for (int r = 0; r < 16; ++r) o[cb][r] = 0.f;
#pragma unroll
        for (int ks = 0; ks < 4; ++ks)
#pragma unroll
            for (int cb = 0; cb < 2; ++cb) o[cb] = __builtin_amdgcn_mfma_f32_32x32x16_bf16(vT[ks], *(const bf16x8*)(SC + (cb * 32 + lq) * 144 + ks * 32 + h * 16), o[cb], 0, 0, 0);
#pragma unroll
        for (int ks = 0; ks < 8; ++ks) {
            const int db = ks >> 1, s8 = (ks & 1) * 8;
            u32x4 pk; pk.x = pk2(st[db][s8 + 0], st[db][s8 + 1]); pk.y = pk2(st[db][s8 + 2], st[db][s8 + 3]); pk.z = pk2(st[db][s8 + 4], st[db][s8 + 5]); pk.w = pk2(st[db][s8 + 6], st[db][s8 + 7]);
            const bf16x8 aS = __builtin_bit_cast(bf16x8, pk);
#pragma unroll
            for (int cb = 0; cb < 2; ++cb) {
                const char* qrow = QF + (cb * 32 + lq) * 272 + ks * 32 + h * 8;
                const u32x2 lo = *(const u32x2*)qrow, hi = *(const u32x2*)(qrow + 16);
                const u32x4 bq = {lo.x, lo.y, hi.x, hi.y};
                o[cb] = __builtin_amdgcn_mfma_f32_32x32x16_bf16(aS, __builtin_bit_cast(bf16x8, bq), o[cb], 0, 0, 0);
            }
        }
#pragma unroll
        for (int cb = 0; cb < 2; ++cb) {
            float ss = 0.f;
#pragma unroll
            for (int r = 0; r < 16; ++r) ss += o[cb][r] * o[cb][r];
            ss += __shfl_xor(ss, 32);
            if (h == 0) atomicAdd(&ssum[cb * 32 + lq], ss);
        }
        }
#pragma unroll
        for (int db = 0; db < 4; ++db) {
#pragma unroll
            for (int i = 0; i < 4; ++i) {
                const f32x4 dv = *(const f32x4*)(dec + db * 32 + 8 * i + 4 * h);
                st[db][4 * i] *= dv.x; st[db][4 * i + 1] *= dv.y; st[db][4 * i + 2] *= dv.z; st[db][4 * i + 3] *= dv.w;
            }
#pragma unroll
            for (int ks = 0; ks < 4; ++ks) st[db] = __builtin_amdgcn_mfma_f32_32x32x16_bf16(*(const bf16x8*)(KD + (db * 32 + lq) * 144 + ks * 32 + h * 16), vT[ks], st[db], 0, 0, 0);
        }
        if (full) {
        __syncthreads();
#pragma unroll
        for (int cb = 0; cb < 2; ++cb) {
            const int c = cb * 32 + lq;
            const float rstd = rsqrtf(ssum[c] * (1.f / 256.f) + EPS);
            bf16_t* gp = p.gg + (tok0 + c) * 1024 + hh * 256;
#pragma unroll
            for (int i = 0; i < 4; ++i) {
                const int e0 = 32 * w + 8 * i + 4 * h;
                const u32x2 gr = ggr[cb][i];
                const f32x4 ng = *(const f32x4*)(p.gla_norm_g + e0);
                u32x2 ov;
                ov.x = pk2(o[cb][4 * i] * rstd * ng.x * __uint_as_float(gr.x << 16), o[cb][4 * i + 1] * rstd * ng.y * __uint_as_float(gr.x & 0xFFFF0000u));
                ov.y = pk2(o[cb][4 * i + 2] * rstd * ng.z * __uint_as_float(gr.y << 16), o[cb][4 * i + 3] * rstd * ng.w * __uint_as_float(gr.y & 0xFFFF0000u));
                *(u32x2*)(gp + e0) = ov;
            }
        }
        }
    }
    __syncthreads();
}

typedef const P __attribute__((address_space(4))) * KernargP;
__device__ __forceinline__ P load_params() {
#if defined(__HIP_DEVICE_COMPILE__)
    KernargP k = (KernargP)__builtin_amdgcn_kernarg_segment_ptr(); asm volatile("" : "+s"(k)); return *k;
#else
    return P{};
#endif
}
__global__ __launch_bounds__(512, 2) void mega(P p_unused, int pb, int pe, int rmask) {
    extern __shared__ __attribute__((aligned(16))) char smem[];
    cg::grid_group grid = cg::this_grid();
    float* fl = (float*)smem;
    for (int ph = pb; ph < pe; ++ph) {
      {
        const P p = load_params();
        switch (ph) {
            case 0: if (blockIdx.x == 0 && threadIdx.x == 0) *p.ctr = 0u; phase_mod(p, fl); __syncthreads(); phase_convert(p, fl); break;
            case 1: phase_norm(p, p.x, p.norm1_g, 0, 1024, p.h); break;
            case 2:
                run_gemm(smem, p.h, p.wt_in1, T, 4352, 1024, FastEpi<EpiP1>{EpiP1{p}});
                run_gemm(smem, p.h, p.wt_in2, T, 2048, 1024, FastEpi<EpiP2>{EpiP2{p}});
                run_gemm(smem, p.wt_gv, p.h, 2048, T, 1024, FastEpiVT{p.gvT, p.dvT});
                break;
            case 3: gla_prepass(p, smem); break;
            case 4:
                if (blockIdx.x < 128) gla_seq(p, smem, (int)blockIdx.x & 31, (int)blockIdx.x >> 5);
                attn_phase(p, smem);
                break;
            case 5:
                run_gemm(smem, p.gg, p.wt_glao, T, 1024, 1024, FastEpi<EpiM1>{EpiM1{p}});
                run_gemm(smem, p.h, p.wt_diffo, T, 1024, 1024, FastEpi<EpiMG>{EpiMG{p}});
                break;
            case 6: run_gemm(smem, p.merged, p.wt_out, T, 1024, 1024, FastEpi<EpiX1>{EpiX1{p}}); break;
            case 7: phase_norm_b(p, p.x1b, p.norm2_g, 3072, 4096, p.h); break;
            case 8: run_gemm(smem, p.h, p.wt_up, T, 5632, 1024, FastEpiUpConv{p, smem + 131072}); break;
            case 9: fixup_phase(p); break;
            case 10: run_gemm(smem, p.act, p.wt_down, T, 1024, 2816, FastEpi<EpiOut>{EpiOut{p}}); break;
        }
      }
        if (ph + 1 < pe) grid.sync();
#ifdef XSYNC
        for (int q = 0; q < XSYNC; ++q) grid.sync();
#endif
    }
}

constexpr size_t MEGA_LDS = 160 * 1024;
#ifndef RMASK
#define RMASK 0
#endif
static int g_grid = 0;
static void launch_mega(const P& p, int pb, int pe, hipStream_t stream) {
    P pp = p; int a = pb, b = pe, rm = RMASK;
    void* args[] = {&pp, &a, &b, &rm};
    hipError_t e = hipLaunchCooperativeKernel((const void*)mega, dim3(g_grid), dim3(512), args, MEGA_LDS, stream);
    if (e != hipSuccess) fprintf(stderr, "cooperative launch failed: %s (grid %d)\n", hipGetErrorString(e), g_grid);
}

extern "C" void kernel_launch(void* const* d_in, const int* in_sizes, int n_in, void* d_out, int out_size, void* d_ws, size_t ws_size, hipStream_t stream) {
    P p{};
    const float** f = (const float**)&p;
    for (int i = 0; i < 24; ++i) f[i] = (const float*)d_in[i];
    p.out = (float*)d_out;
    char* ws = (char*)d_ws; size_t off = 0;
    const size_t MiB = 1u << 20;
    auto take = [&](size_t bytes) { char* r = ws + off; off += (bytes + 255) & ~(size_t)255; return r; };
    p.wt_in1 = (bf16_t*)take((size_t)4352 * 1024 * 2); p.wt_in2 = (bf16_t*)take((size_t)2048 * 1024 * 2);
    p.wt_gv = (bf16_t*)take(2 * MiB); p.wt_dv = (bf16_t*)take(2 * MiB);
    p.wt_glao = (bf16_t*)take(2 * MiB); p.wt_diffo = (bf16_t*)take(2 * MiB); p.wt_out = (bf16_t*)take(2 * MiB);
    p.wt_up = (bf16_t*)take((size_t)5632 * 1024 * 2); p.wt_down = (bf16_t*)take((size_t)1024 * 2816 * 2);
    p.mod = (float*)take(8 * 6144 * 4);
    p.ctr = (unsigned*)take(256);
    off = 40 * MiB;
    p.h = (bf16_t*)take(64 * MiB);
    char* big = ws + off;
    p.gq = (bf16_t*)(big); p.gk = (bf16_t*)(big + 32 * MiB); p.gg = (bf16_t*)(big + 64 * MiB); p.gvT = (bf16_t*)(big + 128 * MiB);
    p.acode = (float*)(big + 192 * MiB); p.decay = (float*)(big + 192 * MiB); p.delta = (bf16_t*)(big + 194 * MiB);
    p.dq = (bf16_t*)(big + 194 * MiB); p.dk = (bf16_t*)(big + 258 * MiB); p.dvT = (bf16_t*)(big + 322 * MiB); p.merged = (bf16_t*)(big);
    p.uh = (bf16_t*)(big); p.act = (bf16_t*)(big + 128 * MiB); p.ubnd = (bf16_t*)(big + 386 * MiB); p.x1b = (bf16_t*)(big + 64 * MiB);
    p.kdtA = (bf16_t*)ws; p.kdtB = (bf16_t*)(big + 386 * MiB); p.decg = (float*)(big + 399 * MiB);
    p.sga = (bf16_t*)d_out; p.sgb = (bf16_t*)d_out + (size_t)T * 1024;
    if (ws_size < 496 * MiB) { fprintf(stderr, "workspace too small: %zu\n", ws_size); return; }

    if (!g_grid) {
        (void)hipFuncSetAttribute((const void*)mega, hipFuncAttributeMaxDynamicSharedMemorySize, (int)MEGA_LDS);
        int dev = 0, cus = 0, per_cu = 0;
        (void)hipGetDevice(&dev);
        (void)hipDeviceGetAttribute(&cus, hipDeviceAttributeMultiprocessorCount, dev);
        (void)hipOccupancyMaxActiveBlocksPerMultiprocessor(&per_cu, mega, 512, MEGA_LDS);
        if (per_cu < 1) per_cu = 1;
        g_grid = cus * per_cu;
    }
    launch_mega(p, 0, 11, stream);
}
```

```cpp
#include <hip/hip_runtime.h>
#include <hip/hip_cooperative_groups.h>
#include <cstdio>
namespace cg = cooperative_groups;

typedef unsigned short bf16_t;
typedef float f32x4 __attribute__((ext_vector_type(4)));
typedef unsigned u32x4 __attribute__((ext_vector_type(4)));
typedef unsigned u32x2 __attribute__((ext_vector_type(2)));

constexpr int T = 32768;
constexpr int DM = 1024;
constexpr int NIN = 8208;
constexpr float EPS = 1e-6f;
constexpr float LOG2E = 1.4426950408889634f;

__device__ __forceinline__ float bf2f(bf16_t v) { return __uint_as_float(((unsigned)v) << 16); }
__device__ __forceinline__ bf16_t f2bf(float f) { unsigned u = __float_as_uint(f); u += 0x7FFFu + ((u >> 16) & 1u); return (bf16_t)(u >> 16); }
typedef float f32x2v __attribute__((ext_vector_type(2)));
typedef __bf16 bf16x2v __attribute__((ext_vector_type(2)));
__device__ __forceinline__ unsigned pk2(float lo, float hi) { const f32x2v v = {lo, hi}; return __builtin_bit_cast(unsigned, __builtin_convertvector(v, bf16x2v)); }
__device__ __forceinline__ float siluf(float v) { return v * __builtin_amdgcn_rcpf(1.f + __builtin_amdgcn_exp2f(-LOG2E * v)); }
__device__ __forceinline__ float sigmf(float v) { return __builtin_amdgcn_rcpf(1.f + __builtin_amdgcn_exp2f(-LOG2E * v)); }
__device__ __forceinline__ float logsigf(float z) { return fminf(z, 0.f) - __logf(1.f + __expf(-fabsf(z))); }

__device__ __forceinline__ int otid() { int t = threadIdx.x; asm volatile("" : "+v"(t)); return t; }

struct P {
    const float *x, *c, *w_ada, *b_ada, *norm1_g, *w_in, *w_alpha_up, *b_alpha, *gla_norm_g, *q_norm_g, *k_norm_g,
        *lam_q1, *lam_k1, *lam_q2, *lam_k2, *diff_norm_g, *w_gla_o, *w_diff_o, *w_out, *norm2_g, *w_up, *conv_w, *conv_b, *w_down;
    float* out;
    bf16_t *wt_in1, *wt_in2, *wt_gv, *wt_dv, *wt_glao, *wt_diffo, *wt_out, *wt_up, *wt_down;
    float* mod;
    bf16_t* h;
    bf16_t *gq, *gk, *gg, *gvT;
    float *acode, *decay;
    bf16_t* delta;
    bf16_t *dq, *dk, *dvT, *merged, *uh, *act;
    bf16_t *sga, *sgb;
    unsigned* ctr;
    bf16_t* ubnd;
    bf16_t *kdtA, *kdtB; float* decg;
    bf16_t* x1b;
};

__host__ __device__ __forceinline__ int tperm(int q, int style) {
    const int bj = q >> 7, wc = (q >> 5) & 3, n = (q >> 4) & 1, fq = (q >> 2) & 3, j = q & 3;
    return style == 0 ? 64 * wc + 32 * bj + 8 * fq + 4 * n + j : 64 * wc + 16 * (2 * bj + n) + 4 * fq + j;
}
__host__ __device__ __forceinline__ int src_logical(int kind, int L) {
    switch (kind) {
        case 0:
            if (L < 1024) return L;
            if (L < 2048) return 2048 + (L - 1024);
            if (L < 3072) return 6160 + (L - 2048);
            if (L < 4096) return 7184 + (L - 3072);
            return (L - 4096) < 16 ? 3072 + (L - 4096) : -1;
        case 1:
            return L < 1024 ? 3088 + L : 4112 + (L - 1024);
        case 4: case 6: return L;
        case 5: { const int ch = 128 * (L >> 8) + ((L & 255) >> 1); return (L & 1) * 2816 + ch; }
    }
    return -1;
}
__host__ __device__ __forceinline__ int src_physical(int kind, int prow) {
    if (kind == 2) return 1024 + prow;
    if (kind == 3) return 5136 + prow;
    return src_logical(kind, (prow & ~255) + tperm(prow & 255, kind == 6 ? 1 : 0));
}

struct RedNaive { static __device__ __forceinline__ float sum4(float x) { x += __shfl_xor(x, 1); x += __shfl_xor(x, 2); return x; } };
struct RedFast  { static __device__ __forceinline__ float sum4(float x) { x += __shfl_xor(x, 16); x += __shfl_xor(x, 32); return x; } };

__device__ __forceinline__ void st16_bf16(bf16_t* dst, const float (&v)[16]) {
    u32x4 a, b;
    a.x = pk2(v[0], v[1]); a.y = pk2(v[2], v[3]); a.z = pk2(v[4], v[5]); a.w = pk2(v[6], v[7]);
    b.x = pk2(v[8], v[9]); b.y = pk2(v[10], v[11]); b.z = pk2(v[12], v[13]); b.w = pk2(v[14], v[15]);
    *(u32x4*)dst = a; *(u32x4*)(dst + 8) = b;
}
__device__ __forceinline__ void st8x2_bf16(bf16_t* dst, const float (&v)[16]) {
    u32x4 a, b;
    a.x = pk2(v[0], v[1]); a.y = pk2(v[2], v[3]); a.z = pk2(v[4], v[5]); a.w = pk2(v[6], v[7]);
    b.x = pk2(v[8], v[9]); b.y = pk2(v[10], v[11]); b.z = pk2(v[12], v[13]); b.w = pk2(v[14], v[15]);
    *(u32x4*)dst = a; *(u32x4*)(dst + 32) = b;
}
__device__ __forceinline__ void ld16_bf16(const bf16_t* src, float (&v)[16]) {
    const u32x4 a = *(const u32x4*)src, b = *(const u32x4*)(src + 8);
    const unsigned w[8] = {a.x, a.y, a.z, a.w, b.x, b.y, b.z, b.w};
#pragma unroll
    for (int i = 0; i < 8; ++i) { v[2 * i] = __uint_as_float(w[i] << 16); v[2 * i + 1] = __uint_as_float(w[i] & 0xFFFF0000u); }
}

__device__ __forceinline__ void unpack16(const u32x4& a, const u32x4& b, float (&v)[16]) {
    const unsigned w[8] = {a.x, a.y, a.z, a.w, b.x, b.y, b.z, b.w};
#pragma unroll
    for (int i = 0; i < 8; ++i) { v[2 * i] = __uint_as_float(w[i] << 16); v[2 * i + 1] = __uint_as_float(w[i] & 0xFFFF0000u); }
}
struct NoCtx {};
struct EpiP1 {
    static constexpr int STYLE = 0;
    P p;
    typedef NoCtx Ctx; typedef NoCtx Pre;
    __device__ __forceinline__ void begin(int seg, int c16, Ctx&) const {}
    __device__ __forceinline__ void pre(int seg, int row, int c16, Pre&) const {}
    __device__ __forceinline__ void fin(int seg, int row, int c16, float (&v)[16], const Pre&, const Ctx&) const {
        if (seg < 2) { st8x2_bf16(p.gq + (size_t)row * 512 + c16, v); }
        else if (seg < 4) { st8x2_bf16(p.gk + (size_t)row * 512 + (c16 - 512), v); }
        else if (seg < 8) {
#pragma unroll
            for (int i = 0; i < 16; ++i) v[i] = siluf(v[i]);
            st8x2_bf16(p.gg + (size_t)row * 1024 + (c16 - 1024), v);
        } else if (seg < 16) {
#pragma unroll
            for (int i = 0; i < 16; ++i) v[i] = sigmf(v[i]);
            bf16_t* dst = seg < 12 ? p.sga + (size_t)row * 1024 + (c16 - 2048) : p.sgb + (size_t)row * 1024 + (c16 - 3072);
            st8x2_bf16(dst, v);
        } else if (c16 == 4096 || c16 == 4104) {
            float* dst = p.acode + (size_t)row * 16 + (c16 - 4096);
            *(f32x4*)dst = (f32x4){v[0], v[1], v[2], v[3]}; *(f32x4*)(dst + 4) = (f32x4){v[4], v[5], v[6], v[7]};
        }
    }
};
struct EpiP2 {
    static constexpr int STYLE = 0;
    P p;
    struct Ctx { float g[16]; };
    typedef NoCtx Pre;
    __device__ __forceinline__ void begin(int seg, int c16, Ctx& c) const {
        const float* g = (seg < 4 ? p.q_norm_g : p.k_norm_g) + (c16 & 63); const float sc = seg < 4 ? 0.125f * LOG2E : 1.f;
#pragma unroll
        for (int i = 0; i < 8; ++i) { c.g[i] = g[i] * sc; c.g[8 + i] = g[32 + i] * sc; }
    }
    __device__ __forceinline__ void pre(int seg, int row, int c16, Pre&) const {}
    __device__ __forceinline__ void fin(int seg, int row, int c16, float (&v)[16], const Pre&, const Ctx& c) const {
        float ss = 0.f;
#pragma unroll
        for (int i = 0; i < 16; ++i) ss += v[i] * v[i];
        ss = RedFast::sum4(ss);
        const float rstd = rsqrtf(ss * (1.f / 64.f) + EPS);
#pragma unroll
        for (int i = 0; i < 16; ++i) v[i] = v[i] * rstd * c.g[i];
        bf16_t* dst = seg < 4 ? p.dq + (size_t)row * 1024 + c16 : p.dk + (size_t)row * 1024 + (c16 - 1024);
        st8x2_bf16(dst, v);
    }
};
struct EpiM1 {
    static constexpr int STYLE = 0;
    P p;
    typedef NoCtx Ctx; struct Pre { u32x4 a, b; };
    __device__ __forceinline__ void begin(int seg, int c16, Ctx&) const {}
    __device__ __forceinline__ void pre(int seg, int row, int c16, Pre& q) const { const bf16_t* s = p.sga + (size_t)row * 1024 + c16; q.a = *(const u32x4*)s; q.b = *(const u32x4*)(s + 32); }
    __device__ __forceinline__ void fin(int seg, int row, int c16, float (&v)[16], const Pre& q, const Ctx&) const {
        float g[16]; unpack16(q.a, q.b, g);
#pragma unroll
        for (int i = 0; i < 16; ++i) v[i] *= g[i];
        st8x2_bf16(p.merged + (size_t)row * 1024 + c16, v);
    }
};
struct EpiMG {
    static constexpr int STYLE = 0;
    P p;
    typedef NoCtx Ctx; struct Pre { u32x4 a, b, c, d; };
    __device__ __forceinline__ void begin(int seg, int c16, Ctx&) const {}
    __device__ __forceinline__ void pre(int seg, int row, int c16, Pre& q) const {
        const bf16_t* s = p.sgb + (size_t)row * 1024 + c16; const bf16_t* m = p.merged + (size_t)row * 1024 + c16;
        q.a = *(const u32x4*)s; q.b = *(const u32x4*)(s + 32); q.c = *(const u32x4*)m; q.d = *(const u32x4*)(m + 32);
    }
    __device__ __forceinline__ void fin(int seg, int row, int c16, float (&v)[16], const Pre& q, const Ctx&) const {
        float g[16], m[16]; unpack16(q.a, q.b, g); unpack16(q.c, q.d, m);
#pragma unroll
        for (int i = 0; i < 16; ++i) v[i] = m[i] + g[i] * v[i];
        st8x2_bf16(p.merged + (size_t)row * 1024 + c16, v);
    }
};
struct EpiRes {
    static constexpr int STYLE = 1;
    P p; const float* src; float* dst; int goff; int pad;
    struct Ctx { f32x4 g[4]; }; struct Pre { f32x4 x[4]; };
    __device__ __forceinline__ void begin(int seg, int c16, Ctx&) const {}
    __device__ __forceinline__ void pre(int seg, int row, int c16, Pre& q) const {
        const float* s = src + (size_t)row * 1024 + c16;
#pragma unroll
        for (int i = 0; i < 4; ++i) q.x[i] = *(const f32x4*)(s + 16 * i);
    }
    __device__ __forceinline__ void fin(int seg, int row, int c16, float (&v)[16], const Pre& q, const Ctx&) const {
        const float* gt = p.mod + (size_t)(row >> 12) * 6144 + goff + c16;
        float* d = dst + (size_t)row * 1024 + c16;
#pragma unroll
        for (int i = 0; i < 4; ++i) {
            const f32x4 gv = *(const f32x4*)(gt + 16 * i);
            f32x4 o; o.x = q.x[i].x + gv.x * v[4 * i]; o.y = q.x[i].y + gv.y * v[4 * i + 1]; o.z = q.x[i].z + gv.z * v[4 * i + 2]; o.w = q.x[i].w + gv.w * v[4 * i + 3];
            *(f32x4*)(d + 16 * i) = o;
        }
    }
};
struct EpiX1 {
    static constexpr int STYLE = 0;
    P p;
    typedef NoCtx Ctx; struct Pre { f32x4 x[4]; };
    __device__ __forceinline__ void begin(int seg, int c16, Ctx&) const {}
    __device__ __forceinline__ void pre(int seg, int row, int c16, Pre& q) const {
        const float* s = p.x + (size_t)row * 1024 + c16;
        q.x[0] = __builtin_nontemporal_load((const f32x4*)s); q.x[1] = __builtin_nontemporal_load((const f32x4*)(s + 4)); q.x[2] = __builtin_nontemporal_load((const f32x4*)(s + 32)); q.x[3] = __builtin_nontemporal_load((const f32x4*)(s + 36));
    }
    __device__ __forceinline__ void fin(int seg, int row, int c16, float (&v)[16], const Pre& q, const Ctx&) const {
        const float* gt = p.mod + (size_t)(row >> 12) * 6144 + 2048 + c16;
#pragma unroll
        for (int i = 0; i < 4; ++i) {
            const f32x4 gv = *(const f32x4*)(gt + (i >> 1) * 32 + (i & 1) * 4);
            v[4 * i] = q.x[i].x + gv.x * v[4 * i]; v[4 * i + 1] = q.x[i].y + gv.y * v[4 * i + 1]; v[4 * i + 2] = q.x[i].z + gv.z * v[4 * i + 2]; v[4 * i + 3] = q.x[i].w + gv.w * v[4 * i + 3];
        }
        st8x2_bf16(p.x1b + (size_t)row * 1024 + c16, v);
    }
};
struct EpiOut {
    static constexpr int STYLE = 1;
    P p;
    typedef NoCtx Ctx; struct Pre { u32x2 x[4]; };
    __device__ __forceinline__ void begin(int seg, int c16, Ctx&) const {}
    __device__ __forceinline__ void pre(int seg, int row, int c16, Pre& q) const {
        const bf16_t* s = p.x1b + (size_t)row * 1024 + c16;
#pragma unroll
        for (int i = 0; i < 4; ++i) q.x[i] = *(const u32x2*)(s + 16 * i);
    }
    __device__ __forceinline__ void fin(int seg, int row, int c16, float (&v)[16], const Pre& q, const Ctx&) const {
        const float* gt = p.mod + (size_t)(row >> 12) * 6144 + 5120 + c16;
        float* d = p.out + (size_t)row * 1024 + c16;
#pragma unroll
        for (int i = 0; i < 4; ++i) {
            const f32x4 gv = *(const f32x4*)(gt + 16 * i);
            f32x4 o;
            o.x = __uint_as_float(q.x[i].x << 16) + gv.x * v[4 * i]; o.y = __uint_as_float(q.x[i].x & 0xFFFF0000u) + gv.y * v[4 * i + 1];
            o.z = __uint_as_float(q.x[i].y << 16) + gv.z * v[4 * i + 2]; o.w = __uint_as_float(q.x[i].y & 0xFFFF0000u) + gv.w * v[4 * i + 3];
            *(f32x4*)(d + 16 * i) = o;
        }
    }
};
struct EpiUp {
    static constexpr int STYLE = 0;
    P p;
    typedef NoCtx Ctx; typedef NoCtx Pre;
    __device__ __forceinline__ void begin(int seg, int c16, Ctx&) const {}
    __device__ __forceinline__ void pre(int seg, int row, int c16, Pre&) const {}
    __device__ __forceinline__ void fin(int seg, int row, int c16, float (&v)[16], const Pre&, const Ctx&) const { st8x2_bf16(p.uh + (size_t)row * 2816 + c16, v); }
};

namespace pg8 {
#define PG8_LAS __attribute__((address_space(3)))
typedef unsigned short bf16_t;
typedef short bf16x8 __attribute__((ext_vector_type(8)));
typedef float f32x4 __attribute__((ext_vector_type(4)));
typedef unsigned u32x4 __attribute__((ext_vector_type(4)));
constexpr int BM = 256, BK = 64, HALF = 128, HTB = HALF * BK * 2  , STAGE_BYTES = 8 * HTB, NXCD = 8, WGM = 8;

__host__ __device__ __forceinline__ int lds_byte(int r, int c) { const int st = (r >> 4) * 2 + (c >> 5), rr = r & 15, cc = c & 31, ob = rr * 64 + cc * 2; return st * 1024 + (ob ^ (((ob >> 9) & 1) << 5)); }
__host__ __device__ __forceinline__ void stage_rc(int b, int& R, int& C) { const int st = b / 1024, sb = b % 1024, swz = sb ^ (((sb >> 9) & 1) << 5); R = (st >> 1) * 16 + swz / 64; C = (st & 1) * 32 + (swz % 64) / 2; }
__host__ __device__ __forceinline__ int perm32(int rho) { const int n = rho >> 4, i = rho & 15; return 8 * (i >> 2) + 4 * n + (i & 3); }

struct Unit { int pm, pn; };
struct Gemm { const bf16_t* A; const bf16_t* Bt; int M, N, K; };

struct StaticOrder {
    int nM, nN, nwg, G, c;
    __host__ __device__ void init(int M, int N, int G_, int c_) { nM = M / BM; nN = N / BM; nwg = nM * nN; G = G_; c = c_; }
    __host__ __device__ bool next(int i, Unit& u) const {
        const long L = (long)i * G + c; if (L >= nwg) return false;
        int wgid = (int)L; { const int q = nwg / NXCD, r = nwg % NXCD, xcd = wgid % NXCD, off = wgid / NXCD; wgid = (xcd < r ? xcd * (q + 1) : r * (q + 1) + (xcd - r) * q) + off; }
        const int nig = WGM * nN, gid = wgid / nig, fm = gid * WGM, gsz = (nM - fm) < WGM ? (nM - fm) : WGM;
        u.pm = fm + ((wgid % nig) % gsz); u.pn = (wgid % nig) / gsz; return true;
    }
    __device__ __forceinline__ void a_ready(const Unit&) const {}
    __device__ __forceinline__ void done(const Unit&) const {}
};

template <class Epi, class Sched, bool STAMP = false>
__device__ __forceinline__ void gemm_phase(PG8_LAS unsigned char* lds, const Gemm g, const Sched& S, const Epi& E, unsigned long long* stamps) {
    int tid_ = threadIdx.x; asm volatile("" : "+v"(tid_));
    const int tid = tid_, wid = __builtin_amdgcn_readfirstlane(tid >> 6), lane = tid & 63, wr = wid >> 2, wc = wid & 3, fr = lane & 15, fq = lane >> 4;
    const int K = g.K, nt = K / BK;
    int ts_lo = 0, ts_hi = 0, nts = 0; const unsigned long long rt_entry = STAMP ? (unsigned long long)wall_clock64() : 0ull;
#define PG8_STAMP() do { if (STAMP && wid == 0 && nts < 64) { const unsigned long long _c = (unsigned long long)clock64(); \
        ts_lo = (lane == nts) ? (int)(unsigned)_c : ts_lo; ts_hi = (lane == nts) ? (int)(unsigned)(_c >> 32) : ts_hi; ++nts; } } while (0)
    PG8_STAMP();
    unsigned voffA[2], voffB[2];
#pragma unroll
    for (int i = 0; i < 2; ++i) { int R, C; stage_rc(tid * 16 + i * 8192, R, C); const int Rb = Epi::PERM ? ((R & ~31) + perm32(R & 31)) : R;
        voffA[i] = (unsigned)(R * K + C) * 2u; voffB[i] = (unsigned)(Rb * K + C) * 2u; }
    const size_t kstep = (size_t)(BK * 2);
    const size_t hstep = (size_t)HALF * K * 2;
    const size_t tstep = 2 * hstep;
    const unsigned ldsw = (unsigned)wid * 1024u;
    const int aoff = lds_byte(wr * 64 + fr, fq * 8), boff = lds_byte(wc * 32 + fr, fq * 8);
#define PG8_SA(b, h) (((b) * 2 + (h)) * HTB)
#define PG8_SB(b, h) ((4 + (b) * 2 + (h)) * HTB)
#define PG8_STAGE(bufoff, gbase, voff) do { _Pragma("unroll") for (int _i = 0; _i < 2; ++_i) \
        __builtin_amdgcn_global_load_lds((const unsigned*)((const char*)(gbase) + (voff)[_i]), (PG8_LAS unsigned*)(lds + (bufoff) + ldsw + _i * 8192), 16, 0, 0); } while (0)
#define PG8_LDA(dst, b, h) do { _Pragma("unroll") for (int m = 0; m < 4; ++m) _Pragma("unroll") for (int k = 0; k < 2; ++k) dst[m][k] = *(const PG8_LAS bf16x8*)(lds + PG8_SA(b, h) + aoff + m * 2048 + k * 1024); } while (0)
#define PG8_LDB(dst, b, h) do { _Pragma("unroll") for (int n = 0; n < 2; ++n) _Pragma("unroll") for (int k = 0; k < 2; ++k) dst[n][k] = *(const PG8_LAS bf16x8*)(lds + PG8_SB(b, h) + boff + n * 2048 + k * 1024); } while (0)
#define PG8_MMA(ai, bj, At, Bt) do { __builtin_amdgcn_s_setprio(1); _Pragma("unroll") for (int m = 0; m < 4; ++m) _Pragma("unroll") for (int n = 0; n < 2; ++n) _Pragma("unroll") for (int k = 0; k < 2; ++k) \
        acc[ai][bj][m][n] = __builtin_amdgcn_mfma_f32_16x16x32_bf16(Bt[n][k], At[m][k], acc[ai][bj][m][n], 0, 0, 0); __builtin_amdgcn_s_setprio(0); } while (0)
#define PG8_WAIT_V(n) asm volatile("s_waitcnt vmcnt(" #n ")" ::: "memory")
#define PG8_WAIT_L(n) asm volatile("s_waitcnt lgkmcnt(" #n ")" ::: "memory")
#define PG8_BAR __builtin_amdgcn_s_barrier()
#define PG8_SCHED __builtin_amdgcn_sched_barrier(0)
    Unit cur, nxt; int ui = 0;
    if (!S.next(0, cur)) return;
    f32x4 acc[2][2][4][2];
#pragma unroll
    for (int a = 0; a < 2; ++a)
#pragma unroll
        for (int b = 0; b < 2; ++b)
#pragma unroll
            for (int m = 0; m < 4; ++m)
#pragma unroll
                for (int n = 0; n < 2; ++n) acc[a][b][m][n] = (f32x4){0.f, 0.f, 0.f, 0.f};
    bf16x8 At[4][2], B0[2][2], B1[2][2];
    const char* cA = (const char*)g.A + (size_t)cur.pm * tstep; const char* cB = (const char*)g.Bt + (size_t)cur.pn * tstep;
    S.a_ready(cur);
    PG8_STAGE(PG8_SB(0, 0), cB, voffB); PG8_STAGE(PG8_SA(0, 0), cA, voffA); PG8_STAGE(PG8_SB(0, 1), cB + hstep, voffB); PG8_STAGE(PG8_SA(0, 1), cA + hstep, voffA);
    if (wr == 1) PG8_BAR;
    PG8_WAIT_V(4); PG8_BAR;
    PG8_STAGE(PG8_SB(1, 0), cB + kstep, voffB); PG8_STAGE(PG8_SA(1, 0), cA + kstep, voffA); PG8_STAGE(PG8_SB(1, 1), cB + hstep + kstep, voffB);
    PG8_WAIT_V(6); PG8_BAR;
    PG8_STAMP();
#ifndef KREP
#define KREP 1
#endif
    int krep = 0;
    for (;;) {
        const bool adv = (krep == KREP - 1);
        bool has_next = true;
        if (adv) has_next = S.next(ui + 1, nxt); else nxt = cur;
        const char* nA = has_next ? (const char*)g.A + (size_t)nxt.pm * tstep : cA; const char* nB = has_next ? (const char*)g.Bt + (size_t)nxt.pn * tstep : cB;
        for (int t = 0; t < nt; t += 2) {
            const bool last = (t == nt - 2);
            const char* a1 = cA + (size_t)(t + 1) * kstep;
            const char* a2 = last ? nA : cA + (size_t)(t + 2) * kstep; const char* b2 = last ? nB : cB + (size_t)(t + 2) * kstep;
            const char* a3 = a2 + kstep; const char* b3 = b2 + kstep;
            if (last && has_next) S.a_ready(nxt);
            PG8_LDB(B0, 0, 0); PG8_SCHED; PG8_LDA(At, 0, 0); PG8_STAGE(PG8_SA(1, 1), a1 + hstep, voffA);
            PG8_WAIT_L(8); PG8_BAR; PG8_WAIT_L(0); PG8_MMA(0, 0, At, B0); PG8_BAR; PG8_SCHED;
            PG8_LDB(B1, 0, 1); PG8_STAGE(PG8_SB(0, 0), b2, voffB);
            PG8_BAR; PG8_WAIT_L(0); PG8_MMA(0, 1, At, B1); PG8_BAR;
            PG8_LDA(At, 0, 1); PG8_STAGE(PG8_SA(0, 0), a2, voffA);
            PG8_BAR; PG8_WAIT_L(0); PG8_MMA(1, 0, At, B0); PG8_BAR; PG8_SCHED;
            PG8_STAGE(PG8_SB(0, 1), b2 + hstep, voffB);
            PG8_WAIT_V(6); PG8_BAR; PG8_MMA(1, 1, At, B1); PG8_BAR;
            PG8_LDB(B0, 1, 0); PG8_SCHED; PG8_LDA(At, 1, 0); PG8_STAGE(PG8_SA(0, 1), a2 + hstep, voffA);
            PG8_WAIT_L(8); PG8_BAR; PG8_WAIT_L(0); PG8_MMA(0, 0, At, B0); PG8_BAR; PG8_SCHED;
            PG8_LDB(B1, 1, 1); PG8_STAGE(PG8_SB(1, 0), b3, voffB);
            PG8_BAR; PG8_WAIT_L(0); PG8_MMA(0, 1, At, B1); PG8_BAR;
            PG8_LDA(At, 1, 1); PG8_STAGE(PG8_SA(1, 0), a3, voffA);
            PG8_BAR; PG8_WAIT_L(0); PG8_MMA(1, 0, At, B0); PG8_BAR; PG8_SCHED;
            PG8_STAGE(PG8_SB(1, 1), b3 + hstep, voffB);
            PG8_WAIT_V(6); PG8_BAR; PG8_MMA(1, 1, At, B1); PG8_BAR;
        }
        PG8_STAMP();
        if (!adv) {
            ++krep;
#pragma unroll
            for (int a = 0; a < 2; ++a)
#pragma unroll
                for (int b = 0; b < 2; ++b)
#pragma unroll
                    for (int m = 0; m < 4; ++m)
#pragma unroll
                        for (int n = 0; n < 2; ++n) acc[a][b][m][n] = (f32x4){0.f, 0.f, 0.f, 0.f};
            continue;
        }
        krep = 0;
        if constexpr (!Epi::AFTER_DRAIN) { E(acc, cur, wr, wc, fr, fq); S.done(cur); }
        PG8_STAMP();
        if (!has_next) break;
#pragma unroll
        for (int a = 0; a < 2; ++a)
#pragma unroll
            for (int b = 0; b < 2; ++b)
#pragma unroll
                for (int m = 0; m < 4; ++m)
#pragma unroll
                    for (int n = 0; n < 2; ++n) acc[a][b][m][n] = (f32x4){0.f, 0.f, 0.f, 0.f};
        cur = nxt; cA = nA; cB = nB; ++ui;
    }
    PG8_WAIT_V(0);
    if (wr == 0) PG8_BAR;
    PG8_BAR;
    if constexpr (Epi::AFTER_DRAIN) { E.fused(acc, cur, wr, wc, fr, fq, lds, wid, lane); S.done(cur); }
    PG8_STAMP();
    if (STAMP && wid == 0) { stamps[lane] = lane < nts ? (((unsigned long long)(unsigned)ts_hi << 32) | (unsigned)ts_lo) : 0ull;
        if (lane == 62) stamps[62] = rt_entry; if (lane == 63) stamps[63] = (unsigned long long)wall_clock64(); }
#undef PG8_STAMP
#undef PG8_SA
#undef PG8_SB
#undef PG8_STAGE
#undef PG8_LDA
#undef PG8_LDB
#undef PG8_MMA
#undef PG8_WAIT_V
#undef PG8_WAIT_L
#undef PG8_BAR
#undef PG8_SCHED
}
}


template <class EPI> struct FastEpi {
    static constexpr bool PERM = false, AFTER_DRAIN = false;
    EPI e;
    __device__ __forceinline__ void operator()(const pg8::f32x4 (&acc)[2][2][4][2], const pg8::Unit& u, int wr, int wc, int fr, int fq) const {
        const int c16 = u.pn * 256 + 64 * wc + (EPI::STYLE == 0 ? 8 : 4) * fq, seg = u.pn;
        const int row0 = u.pm * 256 + wr * 64 + fr;
        typename EPI::Ctx ctx; e.begin(seg, c16, ctx);
        typename EPI::Pre pre[2][2];
        e.pre(seg, row0, c16, pre[0][0]); e.pre(seg, row0 + 16, c16, pre[0][1]);
#pragma unroll
        for (int bt = 0; bt < 4; ++bt) {
            if (bt < 3) {
                const int k = 2 * bt + 2;
                e.pre(seg, row0 + (k >> 2) * 128 + (k & 3) * 16, c16, pre[(bt + 1) & 1][0]); e.pre(seg, row0 + (k >> 2) * 128 + ((k + 1) & 3) * 16, c16, pre[(bt + 1) & 1][1]);
            }
#pragma unroll
            for (int r = 0; r < 2; ++r) {
                const int k = 2 * bt + r, ai = k >> 2, m = k & 3;
                float v[16];
#pragma unroll
                for (int bj = 0; bj < 2; ++bj)
#pragma unroll
                    for (int n = 0; n < 2; ++n)
#pragma unroll
                        for (int j = 0; j < 4; ++j) v[8 * bj + 4 * n + j] = acc[ai][bj][m][n][j];
                e.fin(seg, row0 + ai * 128 + m * 16, c16, v, pre[bt & 1][r], ctx);
            }
        }
    }
};
struct FastEpiUpConv {
    static constexpr bool PERM = false, AFTER_DRAIN = false;
    P p; char* xh;
    __device__ __forceinline__ void operator()(const pg8::f32x4 (&acc)[2][2][4][2], const pg8::Unit& u, int wr, int wc, int fr, int fq) const {
        const int lane = 16 * fq + fr;
        const int src1 = (lane & 48) | ((fr + 15) & 15), src2 = (lane & 48) | ((fr + 14) & 15);
        const int ch0 = 128 * u.pn + 32 * wc + 4 * fq;
        const int row0 = u.pm * 256 + wr * 64 + fr;
        float* xhf = (float*)xh;
        if (fr >= 14) {
#pragma unroll
            for (int ai = 0; ai < 2; ++ai) {
                float* d = xhf + ((((ai * 2 + wr) * 4 + wc) * 4 + fq) * 2 + (fr - 14)) * 16;
#pragma unroll
                for (int bj = 0; bj < 2; ++bj)
#pragma unroll
                    for (int n = 0; n < 2; ++n) *(f32x4*)(d + 8 * bj + 4 * n) = acc[ai][bj][3][n];
            }
        }
        {
            const bool top = (wr == 0 && fr < 2), bot = (wr == 1 && fr >= 14);
            if (top || bot) {
                const int ai = top ? 0 : 1, m = top ? 0 : 3, rsel = top ? fr : fr - 12;
                float v[16];
#pragma unroll
                for (int bj = 0; bj < 2; ++bj)
#pragma unroll
                    for (int n = 0; n < 2; ++n)
#pragma unroll
                        for (int j = 0; j < 4; ++j) v[8 * bj + 4 * n + j] = top ? acc[0][bj][0][n][j] : acc[1][bj][3][n][j];
                (void)ai; (void)m;
                st8x2_bf16(p.ubnd + ((size_t)u.pm * 4 + rsel) * 5632 + u.pn * 256 + 64 * wc + 8 * fq, v);
            }
        }
        asm volatile("s_waitcnt lgkmcnt(0)" ::: "memory");
        __builtin_amdgcn_s_barrier(); __builtin_amdgcn_s_barrier();
        asm volatile("" ::: "memory");
#pragma unroll
        for (int hf = 0; hf < 2; ++hf) {
            const int ch = ch0 + 16 * hf;
            float wa[3][4], wb[3][4], ba[4], bb[4];
#pragma unroll
            for (int j = 0; j < 3; ++j) {
                const f32x4 a = *(const f32x4*)(p.conv_w + j * 5632 + ch), b = *(const f32x4*)(p.conv_w + j * 5632 + 2816 + ch);
                wa[j][0] = a.x; wa[j][1] = a.y; wa[j][2] = a.z; wa[j][3] = a.w; wb[j][0] = b.x; wb[j][1] = b.y; wb[j][2] = b.z; wb[j][3] = b.w;
            }
            { const f32x4 a = *(const f32x4*)(p.conv_b + ch), b = *(const f32x4*)(p.conv_b + 2816 + ch); ba[0] = a.x; ba[1] = a.y; ba[2] = a.z; ba[3] = a.w; bb[0] = b.x; bb[1] = b.y; bb[2] = b.z; bb[3] = b.w; }
#pragma unroll
            for (int ai = 0; ai < 2; ++ai) {
                float t1p[8], t2p[8];
                {
                    const int pb = 2 * ai + wr - 1;
                    if (pb >= 0) {
                        const float* hsrc = xhf + (((pb * 4 + wc) * 4 + fq) * 2) * 16 + 8 * hf;
#pragma unroll
                        for (int k = 0; k < 8; ++k) { const float h2 = hsrc[k], h1 = hsrc[16 + k]; t1p[k] = h1; t2p[k] = fr == 0 ? h2 : h1; }
                    } else {
#pragma unroll
                        for (int k = 0; k < 8; ++k) { t1p[k] = 0.f; t2p[k] = 0.f; }
                    }
                }
#pragma unroll
                for (int m = 0; m < 4; ++m) {
                    float o[4];
#pragma unroll
                    for (int i = 0; i < 4; ++i) {
                        float cur[2], p1[2], p2[2];
#pragma unroll
                        for (int ab = 0; ab < 2; ++ab) {
                            const int k = 2 * i + ab;
                            const float v = acc[ai][hf][m][k >> 2][k & 3];
                            const float t1 = __shfl(v, src1), t2 = __shfl(v, src2);
                            cur[ab] = v; p1[ab] = fr == 0 ? t1p[k] : t1; p2[ab] = fr < 2 ? t2p[k] : t2;
                            t1p[k] = t1; t2p[k] = t2;
                        }
                        const float ca = wa[0][i] * p2[0] + wa[1][i] * p1[0] + wa[2][i] * cur[0] + ba[i];
                        const float cb = wb[0][i] * p2[1] + wb[1][i] * p1[1] + wb[2][i] * cur[1] + bb[i];
                        o[i] = siluf(ca) * cb;
                    }
                    u32x2 ov; ov.x = pk2(o[0], o[1]); ov.y = pk2(o[2], o[3]);
                    *(u32x2*)(p.act + (size_t)(row0 + ai * 128 + m * 16) * 2816 + ch) = ov;
                }
            }
        }
    }
};
__device__ __forceinline__ void fixup_phase(const P& p) {
    const int t_ = otid();
    for (int task = blockIdx.x * 512 + t_; task < 128 * 704; task += gridDim.x * 512) {
        const int pm = task / 704, rem = task % 704, rsel = rem / 352, cg = rem % 352;
        const int ch0 = cg * 8, col = (ch0 >> 7) * 256 + 2 * (ch0 & 127);
        float c0[16], c1[16], h1[16], h2[16];
        ld16_bf16(p.ubnd + ((size_t)pm * 4 + 0) * 5632 + col, c0); ld16_bf16(p.ubnd + ((size_t)pm * 4 + 1) * 5632 + col, c1);
        if (pm & 15) { ld16_bf16(p.ubnd + ((size_t)(pm - 1) * 4 + 3) * 5632 + col, h1); ld16_bf16(p.ubnd + ((size_t)(pm - 1) * 4 + 2) * 5632 + col, h2); }
        else {
#pragma unroll
            for (int k = 0; k < 16; ++k) { h1[k] = 0.f; h2[k] = 0.f; }
        }
        float o[8];
#pragma unroll
        for (int i = 0; i < 8; ++i) {
            const int ch = ch0 + i;
            const float a2 = rsel ? h1[2 * i] : h2[2 * i], a1 = rsel ? c0[2 * i] : h1[2 * i], a0 = rsel ? c1[2 * i] : c0[2 * i];
            const float b2 = rsel ? h1[2 * i + 1] : h2[2 * i + 1], b1 = rsel ? c0[2 * i + 1] : h1[2 * i + 1], b0 = rsel ? c1[2 * i + 1] : c0[2 * i + 1];
            const float ca = p.conv_w[ch] * a2 + p.conv_w[5632 + ch] * a1 + p.conv_w[2 * 5632 + ch] * a0 + p.conv_b[ch];
            const float cb = p.conv_w[2816 + ch] * b2 + p.conv_w[5632 + 2816 + ch] * b1 + p.conv_w[2 * 5632 + 2816 + ch] * b0 + p.conv_b[2816 + ch];
            o[i] = siluf(ca) * cb;
        }
        u32x4 ov; ov.x = pk2(o[0], o[1]); ov.y = pk2(o[2], o[3]); ov.z = pk2(o[4], o[5]); ov.w = pk2(o[6], o[7]);
        *(u32x4*)(p.act + ((size_t)pm * 256 + rsel) * 2816 + ch0) = ov;
    }
}
struct FastEpiVT {
    static constexpr bool PERM = false, AFTER_DRAIN = false, PROBE_TWICE = false;
    bf16_t* gdst; bf16_t* ddst;
    __device__ __forceinline__ void operator()(const pg8::f32x4 (&acc)[2][2][4][2], const pg8::Unit& u, int wr, int wc, int fr, int fq) const {
        const bool gla = u.pm < 4;
#pragma unroll
        for (int ai = 0; ai < 2; ++ai)
#pragma unroll
            for (int m = 0; m < 4; ++m) {
                const size_t row = (size_t)((u.pm & 3) * 256 + ai * 128 + wr * 64 + m * 16 + fr);
#pragma unroll
                for (int bj = 0; bj < 2; ++bj)
#pragma unroll
                    for (int n = 0; n < 2; ++n) {
                        const int col = u.pn * 256 + bj * 128 + wc * 32 + n * 16 + 4 * fq;
                        u32x2 o; o.x = pk2(acc[ai][bj][m][n][0], acc[ai][bj][m][n][1]); o.y = pk2(acc[ai][bj][m][n][2], acc[ai][bj][m][n][3]);
                        bf16_t* dst = gla ? gdst + ((size_t)(col >> 6) * 65536 + row * 64 + (col & 63)) : ddst + (row * T + col);
                        *(u32x2*)dst = o;
                    }
            }
    }
};
template <class FE> __device__ __forceinline__ void run_gemm(char* shm, const bf16_t* A, const bf16_t* Bt, int M, int N, int K, const FE& fe) {
    int c_ = (int)blockIdx.x; asm volatile("" : "+s"(c_));
    pg8::StaticOrder S; S.init(M, N, (int)gridDim.x, c_);
    pg8::gemm_phase<FE, pg8::StaticOrder, false>((PG8_LAS unsigned char*)shm, pg8::Gemm{A, Bt, M, N, K}, S, fe, nullptr);
}

__device__ __forceinline__ void phase_mod(const P& p, float* lds) {
    float* sc = lds; float* red = lds + 8192;
    const int t = otid();
    bool ready = false;
    for (int item = gridDim.x - 1 - blockIdx.x; item < 192; item += gridDim.x) {
        if (!ready) { for (int i = t; i < 8192; i += 512) sc[i] = siluf(p.c[i]); ready = true; __syncthreads(); }
        const int cl = t & 31, ks = t >> 5, col = item * 32 + cl;
        float acc[8];
#pragma unroll
        for (int b = 0; b < 8; ++b) acc[b] = 0.f;
#pragma unroll 8
        for (int k = ks * 64; k < ks * 64 + 64; ++k) {
            const float w = __builtin_nontemporal_load(p.w_ada + (size_t)k * 6144 + col);
#pragma unroll
            for (int b = 0; b < 8; ++b) acc[b] += sc[b * 1024 + k] * w;
        }
#pragma unroll
        for (int b = 0; b < 8; ++b) red[(ks * 8 + b) * 32 + cl] = acc[b];
        __syncthreads();
        if (t < 256) {
            const int b = t >> 5, cc = t & 31; float s = 0.f;
#pragma unroll
            for (int k2 = 0; k2 < 16; ++k2) s += red[(k2 * 8 + b) * 32 + cc];
            p.mod[b * 6144 + item * 32 + cc] = s + p.b_ada[item * 32 + cc];
        }
        __syncthreads();
    }
}
__device__ __forceinline__ void convert_one(const float* W, int ldw, int K, bf16_t* dst, int nrows, int kind, float* lds, int& rot) {
    const int ntk = K / 64, nt = (nrows / 64) * ntk, G = gridDim.x, t = otid();
    int first = (int)blockIdx.x + G - rot; if (first >= G) first -= G;
    for (int tile = first; tile < nt; tile += G) {
        const int tr = tile / ntk, k0 = (tile % ntk) * 64;
        const int pbase = (tr >> 2) * 256 + (tr & 3) * 32;
#define CONV_PROW(pp) (pbase + ((pp) >> 5) * 128 + ((pp) & 31))
        {
            const int pp = t & 63, kq = t >> 6; const int s = src_physical(kind, CONV_PROW(pp));
#pragma unroll
            for (int i = 0; i < 8; ++i) { const int kk = kq + 8 * i; lds[kk * 65 + pp] = s < 0 ? 0.f : __builtin_nontemporal_load(W + (size_t)(k0 + kk) * ldw + s); }
        }
        __syncthreads();
        {
            const int pp = t >> 3, ks = (t & 7) * 8; u32x4 o;
            o.x = pk2(lds[(ks + 0) * 65 + pp], lds[(ks + 1) * 65 + pp]); o.y = pk2(lds[(ks + 2) * 65 + pp], lds[(ks + 3) * 65 + pp]);
            o.z = pk2(lds[(ks + 4) * 65 + pp], lds[(ks + 5) * 65 + pp]); o.w = pk2(lds[(ks + 6) * 65 + pp], lds[(ks + 7) * 65 + pp]);
            *(u32x4*)(dst + (size_t)CONV_PROW(pp) * K + k0 + ks) = o;
        }
        __syncthreads();
    }
    rot += nt; while (rot >= G) rot -= G;
}
__device__ __forceinline__ void phase_convert(const P& p, float* lds) {
    int rot = 0;
    convert_one(p.w_in, NIN, 1024, p.wt_in1, 4352, 0, lds, rot);
    convert_one(p.w_in, NIN, 1024, p.wt_in2, 2048, 1, lds, rot);
    convert_one(p.w_in, NIN, 1024, p.wt_gv, 1024, 2, lds, rot);
    convert_one(p.w_in, NIN, 1024, p.wt_dv, 1024, 3, lds, rot);
    convert_one(p.w_gla_o, 1024, 1024, p.wt_glao, 1024, 4, lds, rot);
    convert_one(p.w_diff_o, 1024, 1024, p.wt_diffo, 1024, 4, lds, rot);
    convert_one(p.w_out, 1024, 1024, p.wt_out, 1024, 4, lds, rot);
    convert_one(p.w_up, 5632, 1024, p.wt_up, 5632, 5, lds, rot);
    convert_one(p.w_down, 1024, 2816, p.wt_down, 1024, 6, lds, rot);
}

__device__ __forceinline__ void phase_norm(const P& p, const float* src, const float* g, int sh_off, int sc_off, bf16_t* dst) {
    const int t_ = otid(), lane = t_ & 63, w = t_ >> 6;
    for (int vb = blockIdx.x; vb < 256; vb += gridDim.x) {
        const int b = vb >> 5;
        const float* md = p.mod + (size_t)b * 6144;
        f32x4 gs[4], sh[4];
#pragma unroll
        for (int i = 0; i < 4; ++i) {
            const int e = i * 256 + lane * 4;
            const f32x4 gg = *(const f32x4*)(g + e), sc = *(const f32x4*)(md + sc_off + e);
            gs[i] = gg * (sc + 1.f); sh[i] = *(const f32x4*)(md + sh_off + e);
        }
        for (int rr = 0; rr < 4; ++rr) {
            f32x4 xv[4][4]; float ss[4];
#pragma unroll
            for (int q = 0; q < 4; ++q) {
                const size_t row = (size_t)vb * 128 + w + 8 * (4 * rr + q);
                ss[q] = 0.f;
#pragma unroll
                for (int i = 0; i < 4; ++i) xv[q][i] = __builtin_nontemporal_load((const f32x4*)(src + row * 1024 + i * 256 + lane * 4));
            }
#pragma unroll
            for (int q = 0; q < 4; ++q) {
#pragma unroll
                for (int i = 0; i < 4; ++i) ss[q] += xv[q][i].x * xv[q][i].x + xv[q][i].y * xv[q][i].y + xv[q][i].z * xv[q][i].z + xv[q][i].w * xv[q][i].w;
#pragma unroll
                for (int o = 32; o >= 1; o >>= 1) ss[q] += __shfl_xor(ss[q], o);
            }
#pragma unroll
            for (int q = 0; q < 4; ++q) {
                const size_t row = (size_t)vb * 128 + w + 8 * (4 * rr + q);
                const float rstd = rsqrtf(ss[q] * (1.f / 1024.f) + EPS);
#pragma unroll
                for (int i = 0; i < 4; ++i) {
                    const f32x4 y = xv[q][i] * rstd * gs[i] + sh[i];
                    u32x2 o; o.x = pk2(y.x, y.y); o.y = pk2(y.z, y.w);
                    *(u32x2*)(dst + row * 1024 + i * 256 + lane * 4) = o;
                }
            }
        }
    }
}

__device__ __forceinline__ void phase_norm_b(const P& p, const bf16_t* src, const float* g, int sh_off, int sc_off, bf16_t* dst) {
    const int t_ = otid(), lane = t_ & 63, w = t_ >> 6;
    for (int vb = blockIdx.x; vb < 256; vb += gridDim.x) {
        const int b = vb >> 5;
        const float* md = p.mod + (size_t)b * 6144;
        f32x4 gs[4], sh[4];
#pragma unroll
        for (int i = 0; i < 4; ++i) {
            const int e = i * 256 + lane * 4;
            const f32x4 gg = *(const f32x4*)(g + e), sc = *(const f32x4*)(md + sc_off + e);
            gs[i] = gg * (sc + 1.f); sh[i] = *(const f32x4*)(md + sh_off + e);
        }
        for (int rr = 0; rr < 4; ++rr) {
            f32x4 xv[4][4]; float ss[4];
#pragma unroll
            for (int q = 0; q < 4; ++q) {
                const size_t row = (size_t)vb * 128 + w + 8 * (4 * rr + q);
                ss[q] = 0.f;
#pragma unroll
                for (int i = 0; i < 4; ++i) {
                    const u32x2 r = *(const u32x2*)(src + row * 1024 + i * 256 + lane * 4);
                    xv[q][i] = (f32x4){__uint_as_float(r.x << 16), __uint_as_float(r.x & 0xFFFF0000u), __uint_as_float(r.y << 16), __uint_as_float(r.y & 0xFFFF0000u)};
                }
            }
#pragma unroll
            for (int q = 0; q < 4; ++q) {
#pragma unroll
                for (int i = 0; i < 4; ++i) ss[q] += xv[q][i].x * xv[q][i].x + xv[q][i].y * xv[q][i].y + xv[q][i].z * xv[q][i].z + xv[q][i].w * xv[q][i].w;
#pragma unroll
                for (int o = 32; o >= 1; o >>= 1) ss[q] += __shfl_xor(ss[q], o);
            }
#pragma unroll
            for (int q = 0; q < 4; ++q) {
                const size_t row = (size_t)vb * 128 + w + 8 * (4 * rr + q);
                const float rstd = rsqrtf(ss[q] * (1.f / 1024.f) + EPS);
#pragma unroll
                for (int i = 0; i < 4; ++i) {
                    const f32x4 y = xv[q][i] * rstd * gs[i] + sh[i];
                    u32x2 o; o.x = pk2(y.x, y.y); o.y = pk2(y.z, y.w);
                    *(u32x2*)(dst + row * 1024 + i * 256 + lane * 4) = o;
                }
            }
        }
    }
}

__device__ __forceinline__ void phase_scan(const P& p) {
    const int t_ = otid();
    for (int task = blockIdx.x * 512 + t_; task < 32 * 4096; task += gridDim.x * 512) {
        const int bh = task >> 12, within = task & 4095, e = within >> 4, d8 = (within & 15) * 8;
        float st[8];
#pragma unroll
        for (int i = 0; i < 8; ++i) st[i] = 0.f;
        for (int n = 0; n < 64; ++n) {
            const size_t ci = (size_t)bh * 64 + n;
            bf16_t* ptr = p.delta + (ci * 256 + e) * 128 + d8;
            const u32x4 dv = *(const u32x4*)ptr;
            const f32x4 d0 = *(const f32x4*)(p.decay + ci * 128 + d8), d1 = *(const f32x4*)(p.decay + ci * 128 + d8 + 4);
            const float dec[8] = {d0.x, d0.y, d0.z, d0.w, d1.x, d1.y, d1.z, d1.w};
            const unsigned w[4] = {dv.x, dv.y, dv.z, dv.w};
            u32x4 o; o.x = pk2(st[0], st[1]); o.y = pk2(st[2], st[3]); o.z = pk2(st[4], st[5]); o.w = pk2(st[6], st[7]);
            *(u32x4*)ptr = o;
#pragma unroll
            for (int i = 0; i < 4; ++i) {
                st[2 * i] = dec[2 * i] * st[2 * i] + __uint_as_float(w[i] << 16);
                st[2 * i + 1] = dec[2 * i + 1] * st[2 * i + 1] + __uint_as_float(w[i] & 0xFFFF0000u);
            }
        }
    }
}

__device__ __forceinline__ void phase_conv(const P& p, int half) {
    const int t_ = otid();
    for (int blk = blockIdx.x; blk < 512; blk += gridDim.x) {
        for (int task = t_; task < 1408; task += 512) {
            const int run = task / 352, cgp = task % 352;
            const int t0 = blk * 64 + run * 16;
            const int chl = cgp * 4, ch = half * 1408 + chl;
            float wa[3][4], wb[3][4], ba[4], bb[4];
#pragma unroll
            for (int j = 0; j < 3; ++j)
#pragma unroll
                for (int i = 0; i < 4; ++i) { wa[j][i] = p.conv_w[j * 5632 + ch + i]; wb[j][i] = p.conv_w[j * 5632 + 2816 + ch + i]; }
#pragma unroll
            for (int i = 0; i < 4; ++i) { ba[i] = p.conv_b[ch + i]; bb[i] = p.conv_b[2816 + ch + i]; }
            float a2[4], a1[4], b2[4], b1[4];
#pragma unroll
            for (int i = 0; i < 4; ++i) { a2[i] = a1[i] = b2[i] = b1[i] = 0.f; }
            if ((t0 & 4095) != 0) {
                const u32x4 r2 = *(const u32x4*)(p.uh + (size_t)(t0 - 2) * 2816 + 2 * chl), r1 = *(const u32x4*)(p.uh + (size_t)(t0 - 1) * 2816 + 2 * chl);
                const unsigned w2[4] = {r2.x, r2.y, r2.z, r2.w}, w1[4] = {r1.x, r1.y, r1.z, r1.w};
#pragma unroll
                for (int i = 0; i < 4; ++i) { a2[i] = __uint_as_float(w2[i] << 16); b2[i] = __uint_as_float(w2[i] & 0xFFFF0000u); a1[i] = __uint_as_float(w1[i] << 16); b1[i] = __uint_as_float(w1[i] & 0xFFFF0000u); }
            }
#pragma unroll
            for (int tt = 0; tt < 16; ++tt) {
                const u32x4 r0 = *(const u32x4*)(p.uh + (size_t)(t0 + tt) * 2816 + 2 * chl);
                const unsigned w0[4] = {r0.x, r0.y, r0.z, r0.w};
                float o[4];
#pragma unroll
                for (int i = 0; i < 4; ++i) {
                    const float a0 = __uint_as_float(w0[i] << 16), b0 = __uint_as_float(w0[i] & 0xFFFF0000u);
                    const float ca = wa[0][i] * a2[i] + wa[1][i] * a1[i] + wa[2][i] * a0 + ba[i];
                    const float cb = wb[0][i] * b2[i] + wb[1][i] * b1[i] + wb[2][i] * b0 + bb[i];
                    o[i] = siluf(ca) * cb;
                    a2[i] = a1[i]; a1[i] = a0; b2[i] = b1[i]; b1[i] = b0;
                }
                u32x2 ov; ov.x = pk2(o[0], o[1]); ov.y = pk2(o[2], o[3]);
                *(u32x2*)(p.act + (size_t)(t0 + tt) * 2816 + ch) = ov;
            }
        }
    }
}

__device__ __forceinline__ void simple_bcum(const P& p, int t, int hh, size_t tok0, float* bc, float* ac, float* wup) {
    for (int i = t; i < 1024; i += 512) ac[i] = p.acode[tok0 * 16 + i];
    for (int i = t; i < 2048; i += 512) wup[i] = p.w_alpha_up[(i >> 7) * 512 + hh * 128 + (i & 127)];
    __syncthreads();
    {
        const int d = t & 127, qt = t >> 7; const float ba = p.b_alpha[hh * 128 + d];
        for (int c = qt * 16; c < qt * 16 + 16; ++c) {
            float z = ba;
#pragma unroll
            for (int r = 0; r < 16; ++r) z += ac[c * 16 + r] * wup[r * 128 + d];
            bc[c * 129 + d] = logsigf(z) * (1.f / 16.f);
        }
    }
    __syncthreads();
    if (t < 128) { float run = 0.f; for (int c = 0; c < 64; ++c) { run += bc[c * 129 + t]; bc[c * 129 + t] = run; } }
    __syncthreads();
}
__device__ __forceinline__ void simple_g1(const P& p, float* sm) {
    float* kk = sm; float* bc = kk + 64 * 129; float* ac = bc + 64 * 129; float* wup = ac + 1024;
    const int t = otid();
    for (int ci = blockIdx.x; ci < 2048; ci += gridDim.x) {
        const int bh = ci >> 6, n = ci & 63, b = bh >> 2, hh = bh & 3;
        const size_t tok0 = (size_t)b * 4096 + n * 64;
        __syncthreads();
        for (int i = t; i < 8192; i += 512) { const int c = i >> 7, d = i & 127; kk[c * 129 + d] = bf2f(p.gk[(tok0 + c) * 512 + hh * 128 + d]); }
        simple_bcum(p, t, hh, tok0, bc, ac, wup);
        for (int i = t; i < 8192; i += 512) { const int c = i >> 7, d = i & 127; kk[c * 129 + d] *= __expf(bc[63 * 129 + d] - bc[c * 129 + d]); }
        if (t < 128) p.decay[(size_t)ci * 128 + t] = __expf(bc[63 * 129 + t]);
        __syncthreads();
        const int d = t & 127;
        for (int e = t >> 7; e < 256; e += 4) {
            const bf16_t* vr = p.gvT + (size_t)(hh * 256 + e) * T + tok0;
            float s = 0.f;
            for (int c = 0; c < 64; ++c) s += bf2f(vr[c]) * kk[c * 129 + d];
            p.delta[((size_t)ci * 256 + e) * 128 + d] = f2bf(s);
        }
    }
}
__device__ __forceinline__ void simple_g3(const P& p, float* sm) {
    float* qq = sm; float* kk = qq + 64 * 129; float* bc = kk + 64 * 129; float* sc = bc + 64 * 129; float* ac = sc + 64 * 65; float* wup = ac + 1024; float* ssum = wup + 2048;
    const int t = otid();
    for (int ci = blockIdx.x; ci < 2048; ci += gridDim.x) {
        const int bh = ci >> 6, n = ci & 63, b = bh >> 2, hh = bh & 3;
        const size_t tok0 = (size_t)b * 4096 + n * 64;
        __syncthreads();
        for (int i = t; i < 8192; i += 512) {
            const int c = i >> 7, d = i & 127;
            qq[c * 129 + d] = bf2f(p.gq[(tok0 + c) * 512 + hh * 128 + d]); kk[c * 129 + d] = bf2f(p.gk[(tok0 + c) * 512 + hh * 128 + d]);
        }
        if (t < 64) ssum[t] = 0.f;
        simple_bcum(p, t, hh, tok0, bc, ac, wup);
        const float scale = 0.08838834764831845f;
        for (int i = t; i < 4096; i += 512) {
            const int c = i >> 6, s = i & 63; float a = 0.f;
            for (int d = 0; d < 128; ++d) a += qq[c * 129 + d] * kk[s * 129 + d] * __expf(-fabsf(bc[c * 129 + d] - bc[s * 129 + d]));
            sc[c * 65 + s] = a * scale;
        }
        __syncthreads();
        for (int i = t; i < 8192; i += 512) { const int c = i >> 7, d = i & 127; qq[c * 129 + d] *= scale * __expf(bc[c * 129 + d]); }
        __syncthreads();
        float* o = kk;
        {
            const int e = t & 255, ch = t >> 8;
            const bf16_t* vr = p.gvT + (size_t)(hh * 256 + e) * T + tok0;
            const bf16_t* sr = p.delta + ((size_t)ci * 256 + e) * 128;
            for (int c = ch * 32; c < ch * 32 + 32; ++c) {
                float a = 0.f;
                for (int s = 0; s < 64; ++s) a += sc[c * 65 + s] * bf2f(vr[s]);
                for (int d = 0; d < 128; ++d) a += qq[c * 129 + d] * bf2f(sr[d]);
                o[c * 256 + e] = a; atomicAdd(&ssum[c], a * a);
            }
        }
        __syncthreads();
        for (int i = t; i < 16384; i += 512) {
            const int c = i >> 8, e = i & 255;
            bf16_t* gp = p.gg + (tok0 + c) * 1024 + hh * 256 + e;
            *gp = f2bf(o[i] * rsqrtf(ssum[c] * (1.f / 256.f) + EPS) * p.gla_norm_g[e] * bf2f(*gp));
        }
    }
}

__device__ __forceinline__ float lambda_full(const P& p) {
    float s1 = 0.f, s2 = 0.f;
    for (int i = 0; i < 64; ++i) { s1 += p.lam_q1[i] * p.lam_k1[i]; s2 += p.lam_q2[i] * p.lam_k2[i]; }
    return __expf(s1) - __expf(s2) + 0.2f;
}
__device__ __forceinline__ void simple_attn(const P& p, float* sm) {
    float* qs = sm; float* ks = qs + 2 * 64 * 65; float* vs = ks + 2 * 64 * 65;
    const int t = otid(), r = t & 63, part = t >> 6, j = part & 1, eq = part >> 1;
    const float lam = lambda_full(p);
    for (int item = blockIdx.x; item < 4096; item += gridDim.x) {
        const int c = 63 - (item >> 6), bh = item & 63, b = bh >> 3, hh = bh & 7;
        const size_t tok0 = (size_t)b * 4096 + c * 64;
        __syncthreads();
        for (int i = t; i < 8192; i += 512) { const int jj = i >> 12, rr = (i >> 6) & 63, d = i & 63; qs[(jj * 64 + rr) * 65 + d] = bf2f(p.dq[(tok0 + rr) * 1024 + hh * 128 + jj * 64 + d]); }
        const float sl2 = exp2f(-(float)(hh + 1)) * LOG2E;
        float m = -INFINITY, l = 0.f, acc[32];
#pragma unroll
        for (int e = 0; e < 32; ++e) acc[e] = 0.f;
        const int qpos = c * 64 + r;
        for (int kt = 0; kt <= c; ++kt) {
            __syncthreads();
            for (int i = t; i < 8192; i += 512) { const int jj = i >> 12, ss = (i >> 6) & 63, d = i & 63; ks[(jj * 64 + ss) * 65 + d] = bf2f(p.dk[((size_t)b * 4096 + kt * 64 + ss) * 1024 + hh * 128 + jj * 64 + d]); }
            for (int i = t; i < 8192; i += 512) { const int ss = i & 63, e = i >> 6; vs[ss * 128 + e] = bf2f(p.dvT[(size_t)(hh * 128 + e) * T + (size_t)b * 4096 + kt * 64 + ss]); }
            __syncthreads();
            for (int s = 0; s < 64; ++s) {
                float dot = 0.f;
#pragma unroll
                for (int d = 0; d < 64; ++d) dot += qs[(j * 64 + r) * 65 + d] * ks[(j * 64 + s) * 65 + d];
                const int kpos = kt * 64 + s;
                const float lg = dot - sl2 * fabsf((float)(qpos - kpos));
                if (lg > m) {
                    const float a = exp2f(m - lg); l *= a;
#pragma unroll
                    for (int e = 0; e < 32; ++e) acc[e] *= a;
                    m = lg;
                }
                const float pp = exp2f(lg - m); l += pp;
#pragma unroll
                for (int e = 0; e < 32; ++e) acc[e] += pp * vs[s * 128 + eq * 32 + e];
            }
        }
        __syncthreads();
        float* buf = ks; float* ssum = qs;
        const float inv = 1.f / l;
        if (j == 1) {
#pragma unroll
            for (int e = 0; e < 32; ++e) buf[r * 128 + eq * 32 + e] = lam * acc[e] * inv;
        }
        if (t < 64) ssum[t] = 0.f;
        __syncthreads();
        if (j == 0) {
            float ss = 0.f;
#pragma unroll
            for (int e = 0; e < 32; ++e) { acc[e] = acc[e] * inv - buf[r * 128 + eq * 32 + e]; ss += acc[e] * acc[e]; }
            atomicAdd(&ssum[r], ss);
        }
        __syncthreads();
        if (j == 0) {
            const float rstd = rsqrtf(ssum[r] * (1.f / 128.f) + EPS) * 0.8f;
            bf16_t* dst = p.dq + (tok0 + r) * 1024 + hh * 128 + eq * 32;
#pragma unroll
            for (int e = 0; e < 32; ++e) dst[e] = f2bf(acc[e] * rstd * p.diff_norm_g[eq * 32 + e]);
        }
    }
}

typedef short bf16x8 __attribute__((ext_vector_type(8)));
typedef float f32x16 __attribute__((ext_vector_type(16)));
__device__ __forceinline__ unsigned cvtpk(float lo, float hi) { return pk2(lo, hi); }
__device__ __forceinline__ void attn_phase(const P& p, char* smem) {
    constexpr int KBYTES = 64 * 272, VBYTES = 128 * 144, TBYTES = KBYTES + VBYTES;
    const int t = otid(), lane = t & 63, w = t >> 6, j = w & 1, g = w >> 1, lq = lane & 31, h = lane >> 5;
    const float lam = lambda_full(p);
    float gqm = 0.f, gkm = 0.f;
    for (int i = 0; i < 64; ++i) { gqm = fmaxf(gqm, fabsf(p.q_norm_g[i])); gkm = fmaxf(gkm, fabsf(p.k_norm_g[i])); }
    const float thr = 2.f * (64.f * 0.125f * LOG2E * gqm * gkm * 1.03f) + 152.f;
    int* qslot = (int*)(smem + 2 * TBYTES);
    if (t == 0) qslot[0] = (int)atomicAdd(p.ctr, 1u);
    __syncthreads();
    int idx = qslot[0], par = 0;
    while (idx < 2048) {
        int nxt_item = 0;
        if (t == 0) nxt_item = (int)atomicAdd(p.ctr, 1u);
        const int qb = 31 - (idx >> 6), bh = idx & 63, b = bh >> 3, hh = bh & 7;
        const int q0 = qb * 128;
        const size_t tokq = (size_t)b * 4096 + q0 + 32 * g + lq;
        bf16x8 qf[4];
#pragma unroll
        for (int ks = 0; ks < 4; ++ks) qf[ks] = *(const bf16x8*)(p.dq + tokq * 1024 + hh * 128 + j * 64 + ks * 16 + h * 8);
        const int cw = 2 * qb + (g >> 1), ktmax = 2 * qb + 1;
        const float sl2 = exp2f(-(float)(hh + 1)) * LOG2E;
        const int xk = q0 - 63 - (int)ceilf(thr / sl2);
        const int ktmin = xk <= 0 ? 0 : (xk + 63) >> 6;
        f32x16 cinit;
#pragma unroll
        for (int r = 0; r < 16; ++r) cinit[r] = sl2 * (float)((r & 3) + 8 * (r >> 2));
        f32x16 O[4];
#pragma unroll
        for (int eb = 0; eb < 4; ++eb)
#pragma unroll
            for (int r = 0; r < 16; ++r) O[eb][r] = 0.f;
        float m = -INFINITY, l = 0.f;
        const bf16_t* kbase = p.dk + (size_t)b * 4096 * 1024 + hh * 128; const bf16_t* vbase = p.dvT + (size_t)hh * 128 * T + (size_t)b * 4096;
        int ksrc[2], vsrc[2], kdst[2], vdst[2];
#pragma unroll
        for (int i = 0; i < 2; ++i) {
            const int ck = t + 512 * i;
            { const int row = ck >> 4, cc = ck & 15; ksrc[i] = row * 1024 + cc * 8; kdst[i] = row * 272 + cc * 16; }
            { const int e = ck >> 3, cc = ck & 7; vsrc[i] = e * T + cc * 8; vdst[i] = KBYTES + e * 144 + (cc >> 1) * 32 + (cc & 1) * 8; }
        }
        {
            u32x4 kr[2], vr[2];
#pragma unroll
            for (int i = 0; i < 2; ++i) { kr[i] = *(const u32x4*)(kbase + (size_t)ktmax * 64 * 1024 + ksrc[i]); vr[i] = *(const u32x4*)(vbase + ktmax * 64 + vsrc[i]); }
#pragma unroll
            for (int i = 0; i < 2; ++i) {
                *(u32x4*)(smem + kdst[i]) = kr[i];
                *(u32x2*)(smem + vdst[i]) = (u32x2){vr[i].x, vr[i].y}; *(u32x2*)(smem + vdst[i] + 16) = (u32x2){vr[i].z, vr[i].w};
            }
        }
        __syncthreads();
        int cur = 0;
        for (int kt = ktmax; kt >= ktmin; --kt) {
            u32x4 kr[2], vr[2];
            if (kt > ktmin) {
#pragma unroll
                for (int i = 0; i < 2; ++i) { kr[i] = *(const u32x4*)(kbase + (size_t)(kt - 1) * 64 * 1024 + ksrc[i]); vr[i] = *(const u32x4*)(vbase + (kt - 1) * 64 + vsrc[i]); }
            }
            if (kt <= cw) {
                const char* Kb = smem + cur * TBYTES; const char* Vb = Kb + KBYTES;
                f32x16 S[2];
#pragma unroll
                for (int kb = 0; kb < 2; ++kb) {
                    S[kb] = cinit;
#pragma unroll
                    for (int ks = 0; ks < 4; ++ks) {
                        const bf16x8 a = *(const bf16x8*)(Kb + (kb * 32 + lq) * 272 + j * 128 + ks * 32 + h * 16);
                        S[kb] = __builtin_amdgcn_mfma_f32_32x32x16_bf16(a, qf[ks], S[kb], 0, 0, 0);
                    }
                }
                if (kt == cw) {
                    int qi = 32 * (g & 1) + lq; asm volatile("" : "+v"(qi));
#pragma unroll
                    for (int kb = 0; kb < 2; ++kb)
#pragma unroll
                        for (int r = 0; r < 16; ++r) {
                            const int keyi = kb * 32 + (r & 3) + 8 * (r >> 2) + 4 * h;
                            S[kb][r] += 2.f * sl2 * fminf((float)(qi - keyi), 0.f);
                        }
                }
                const float base0 = sl2 * (float)(kt * 64 + 4 * h - q0), base1 = base0 + sl2 * 32.f;
                float mx0 = S[0][0], mx1 = S[1][0];
#pragma unroll
                for (int r = 1; r < 16; ++r) { mx0 = fmaxf(mx0, S[0][r]); mx1 = fmaxf(mx1, S[1][r]); }
                float mloc = fmaxf(mx0 + base0, mx1 + base1);
                mloc = fmaxf(mloc, __shfl_xor(mloc, 32));
                const float mnew = fmaxf(m, mloc);
                if (__any(mnew > m)) {
                    const float alpha = __builtin_amdgcn_exp2f(m - mnew);
                    l *= alpha;
#pragma unroll
                    for (int eb = 0; eb < 4; ++eb)
#pragma unroll
                        for (int r = 0; r < 16; ++r) O[eb][r] *= alpha;
                }
                m = mnew;
                const float off0 = base0 - m, off1 = base1 - m;
                float ls = 0.f;
#pragma unroll
                for (int r = 0; r < 16; ++r) { S[0][r] = __builtin_amdgcn_exp2f(S[0][r] + off0); S[1][r] = __builtin_amdgcn_exp2f(S[1][r] + off1); ls += S[0][r] + S[1][r]; }
                l += ls;
                bf16x8 pf[4];
#pragma unroll
                for (int kk = 0; kk < 4; ++kk) {
                    const int kb = kk >> 1, s8 = (kk & 1) * 8;
                    u32x4 pk; pk.x = cvtpk(S[kb][s8 + 0], S[kb][s8 + 1]); pk.y = cvtpk(S[kb][s8 + 2], S[kb][s8 + 3]); pk.z = cvtpk(S[kb][s8 + 4], S[kb][s8 + 5]); pk.w = cvtpk(S[kb][s8 + 6], S[kb][s8 + 7]);
                    pf[kk] = __builtin_bit_cast(bf16x8, pk);
                }
#pragma unroll
                for (int eb = 0; eb < 4; ++eb)
#pragma unroll
                    for (int kk = 0; kk < 4; ++kk) {
                        const bf16x8 a = *(const bf16x8*)(Vb + (eb * 32 + lq) * 144 + kk * 32 + h * 16);
                        O[eb] = __builtin_amdgcn_mfma_f32_32x32x16_bf16(a, pf[kk], O[eb], 0, 0, 0);
                    }
            }
            if (kt > ktmin) {
                char* nb = smem + (cur ^ 1) * TBYTES;
#pragma unroll
                for (int i = 0; i < 2; ++i) {
                    *(u32x4*)(nb + kdst[i]) = kr[i];
                    *(u32x2*)(nb + vdst[i]) = (u32x2){vr[i].x, vr[i].y}; *(u32x2*)(nb + vdst[i] + 16) = (u32x2){vr[i].z, vr[i].w};
                }
            }
            __syncthreads();
            cur ^= 1;
        }
        l += __shfl_xor(l, 32);
        const float inv = 1.f / l;
        float* ob = (float*)smem;
        if (j == 1) {
            const float sc = lam * inv;
#pragma unroll
            for (int eb = 0; eb < 4; ++eb)
#pragma unroll
                for (int r = 0; r < 16; ++r) { const int e = eb * 32 + (r & 3) + 8 * (r >> 2) + 4 * h; ob[(g * 128 + e) * 32 + lq] = O[eb][r] * sc; }
        }
        __syncthreads();
        if (j == 0) {
            float ss = 0.f;
#pragma unroll
            for (int eb = 0; eb < 4; ++eb)
#pragma unroll
                for (int r = 0; r < 16; ++r) { const int e = eb * 32 + (r & 3) + 8 * (r >> 2) + 4 * h; const float o = O[eb][r] * inv - ob[(g * 128 + e) * 32 + lq]; O[eb][r] = o; ss += o * o; }
            ss += __shfl_xor(ss, 32);
            const float rstd = rsqrtf(ss * (1.f / 128.f) + EPS) * 0.8f;
            bf16_t* dst = p.h + tokq * 1024 + hh * 128;
#pragma unroll
            for (int eb = 0; eb < 4; ++eb)
#pragma unroll
                for (int i = 0; i < 4; ++i) {
                    const int e0 = eb * 32 + 8 * i + 4 * h;
                    const f32x4 gv = *(const f32x4*)(p.diff_norm_g + e0);
                    u32x2 o; o.x = pk2(O[eb][4 * i] * rstd * gv.x, O[eb][4 * i + 1] * rstd * gv.y); o.y = pk2(O[eb][4 * i + 2] * rstd * gv.z, O[eb][4 * i + 3] * rstd * gv.w);
                    *(u32x2*)(dst + e0) = o;
                }
        }
        if (t == 0) qslot[par ^ 1] = nxt_item;
        __syncthreads();
        idx = qslot[par ^ 1]; par ^= 1;
    }
}

template <int CTRL, int ROWMASK> __device__ __forceinline__ float dpp_add(float x) {
    return x + __builtin_bit_cast(float, __builtin_amdgcn_update_dpp(0, __builtin_bit_cast(int, x), CTRL, ROWMASK, 0xf, false));
}
__device__ __forceinline__ float wave_incl_scan(float x) {
    x = dpp_add<0x111, 0xf>(x); x = dpp_add<0x112, 0xf>(x); x = dpp_add<0x114, 0xf>(x); x = dpp_add<0x118, 0xf>(x);
    x = dpp_add<0x142, 0xa>(x); x = dpp_add<0x143, 0xc>(x);
    return x;
}
__device__ __forceinline__ void gla_load_ac(const P& p, size_t tok0, int lane, float (&ac)[16]) {
#pragma unroll
    for (int i = 0; i < 4; ++i) { const f32x4 v = *(const f32x4*)(p.acode + (tok0 + lane) * 16 + 4 * i); ac[4 * i] = v.x; ac[4 * i + 1] = v.y; ac[4 * i + 2] = v.z; ac[4 * i + 3] = v.w; }
}
__device__ __forceinline__ void gla_gate4(const float* wl, int d0, int lane, const float (&ac)[16], float (&B4)[4]) {
    f32x4 z = *(const f32x4*)(wl + 8192 + d0);
#pragma unroll
    for (int r = 0; r < 16; ++r) { const f32x4 wv = *(const f32x4*)(wl + r * 512 + d0); z.x += ac[r] * wv.x; z.y += ac[r] * wv.y; z.z += ac[r] * wv.z; z.w += ac[r] * wv.w; }
    const float zz[4] = {z.x, z.y, z.z, z.w};
#pragma unroll
    for (int i = 0; i < 4; ++i) B4[i] = wave_incl_scan(logsigf(zz[i]) * (1.f / 16.f));
}
__device__ __forceinline__ void gla_stage_w(const P& p, float* wl, int t) {
    for (int i = t; i < 8192; i += 512) wl[i] = p.w_alpha_up[i];
    wl[8192 + t] = p.b_alpha[t];
}
__device__ __forceinline__ void ldbf16x16(const bf16_t* src, float (&v)[16]) { ld16_bf16(src, v); }
__device__ __forceinline__ void g1_phase(const P& p, char* smem) {
    char* KD = smem;
    const int t = otid(), lane = t & 63, w = __builtin_amdgcn_readfirstlane(t >> 6), lq = lane & 31, h = lane >> 5;
    float* wl = (float*)(smem + 20480); gla_stage_w(p, wl, t);
    for (int ci = blockIdx.x; ci < 2048; ci += gridDim.x) {
        const int bh = ci >> 6, n = ci & 63, b = bh >> 2, hh = bh & 3;
        const size_t tok0 = (size_t)b * 4096 + n * 64;
        __syncthreads();
        bf16x8 bV[4];
#pragma unroll
        for (int ks = 0; ks < 4; ++ks) bV[ks] = *(const bf16x8*)(p.gvT + (tok0 >> 6) * 65536 + (size_t)(hh * 256 + 32 * w + lq) * 64 + ks * 16 + h * 8);
        {
            float ac[16]; gla_load_ac(p, tok0, lane, ac);
            const bf16_t* kp = p.gk + (tok0 + lane) * 512 + hh * 128 + 16 * w;
            const u32x4 kA = *(const u32x4*)kp, kB = *(const u32x4*)(kp + 8);
#pragma unroll 1
            for (int grp = 0; grp < 4; ++grp) {
                const int dl = 16 * w + 4 * grp;
                u32x2 kr; kr.x = grp == 0 ? kA.x : grp == 1 ? kA.z : grp == 2 ? kB.x : kB.z; kr.y = grp == 0 ? kA.y : grp == 1 ? kA.w : grp == 2 ? kB.y : kB.w;
                float B4[4]; gla_gate4(wl, hh * 128 + dl, lane, ac, B4);
                const float kv[4] = {__uint_as_float(kr.x << 16), __uint_as_float(kr.x & 0xFFFF0000u), __uint_as_float(kr.y << 16), __uint_as_float(kr.y & 0xFFFF0000u)};
#pragma unroll
                for (int i = 0; i < 4; ++i) {
                    const float Bl = __shfl(B4[i], 63);
                    *(bf16_t*)(KD + (dl + i) * 144 + lane * 2) = f2bf(kv[i] * __expf(Bl - B4[i]));
                    if (lane == 63) p.decay[(size_t)ci * 128 + dl + i] = __expf(B4[i]);
                }
            }
        }
        __syncthreads();
        bf16_t* drow = p.delta + ((size_t)ci * 256 + 32 * w + lq) * 128;
#pragma unroll
        for (int db = 0; db < 4; ++db) {
            f32x16 acc;
#pragma unroll
            for (int r = 0; r < 16; ++r) acc[r] = 0.f;
#pragma unroll
            for (int ks = 0; ks < 4; ++ks) {
                const bf16x8 a = *(const bf16x8*)(KD + (db * 32 + lq) * 144 + ks * 32 + h * 16);
                acc = __builtin_amdgcn_mfma_f32_32x32x16_bf16(a, bV[ks], acc, 0, 0, 0);
            }
#pragma unroll
            for (int i = 0; i < 4; ++i) {
                u32x2 o; o.x = pk2(acc[4 * i], acc[4 * i + 1]); o.y = pk2(acc[4 * i + 2], acc[4 * i + 3]);
                *(u32x2*)(drow + db * 32 + 8 * i + 4 * h) = o;
            }
        }
    }
}
__device__ __forceinline__ void g3_phase(const P& p, char* smem) {
    constexpr int AB = 64 * 272;
    char* QF = smem; char* KF = smem + AB; char* QB = smem + 2 * AB; char* KBW = smem + 3 * AB; char* SC = smem + 4 * AB; float* ssum = (float*)(smem + 4 * AB + 64 * 144);
    const int t = otid(), lane = t & 63, w = __builtin_amdgcn_readfirstlane(t >> 6), lq = lane & 31, h = lane >> 5;
    const float scale = 0.08838834764831845f;
    float* wl = (float*)(smem + 81920); gla_stage_w(p, wl, t);
    for (int ci = blockIdx.x; ci < 2048; ci += gridDim.x) {
        const int bh = ci >> 6, n = ci & 63, b = bh >> 2, hh = bh & 3;
        const size_t tok0 = (size_t)b * 4096 + n * 64;
        __syncthreads();
        if (t < 64) ssum[t] = 0.f;
        bf16x8 aV[4], aS[8];
#pragma unroll
        for (int ks = 0; ks < 4; ++ks) aV[ks] = *(const bf16x8*)(p.gvT + (tok0 >> 6) * 65536 + (size_t)(hh * 256 + 32 * w + lq) * 64 + ks * 16 + h * 8);
#pragma unroll
        for (int ks = 0; ks < 8; ++ks) aS[ks] = *(const bf16x8*)(p.delta + ((size_t)ci * 256 + 32 * w + lq) * 128 + ks * 16 + h * 8);
        {
            float ac[16]; gla_load_ac(p, tok0, lane, ac);
            const bf16_t* qp = p.gq + (tok0 + lane) * 512 + hh * 128 + 16 * w; const bf16_t* kp = p.gk + (tok0 + lane) * 512 + hh * 128 + 16 * w;
            const u32x4 qA = *(const u32x4*)qp, qB = *(const u32x4*)(qp + 8), kA = *(const u32x4*)kp, kB = *(const u32x4*)(kp + 8);
#pragma unroll 1
            for (int grp = 0; grp < 4; ++grp) {
                const int dl = 16 * w + 4 * grp;
                u32x2 qr, kr;
                qr.x = grp == 0 ? qA.x : grp == 1 ? qA.z : grp == 2 ? qB.x : qB.z; qr.y = grp == 0 ? qA.y : grp == 1 ? qA.w : grp == 2 ? qB.y : qB.w;
                kr.x = grp == 0 ? kA.x : grp == 1 ? kA.z : grp == 2 ? kB.x : kB.z; kr.y = grp == 0 ? kA.y : grp == 1 ? kA.w : grp == 2 ? kB.y : kB.w;
                float B4[4]; gla_gate4(wl, hh * 128 + dl, lane, ac, B4);
                const float qv[4] = {__uint_as_float(qr.x << 16), __uint_as_float(qr.x & 0xFFFF0000u), __uint_as_float(qr.y << 16), __uint_as_float(qr.y & 0xFFFF0000u)};
                const float kv[4] = {__uint_as_float(kr.x << 16), __uint_as_float(kr.x & 0xFFFF0000u), __uint_as_float(kr.y << 16), __uint_as_float(kr.y & 0xFFFF0000u)};
                float a0[4], a1[4], a2[4], a3[4];
#pragma unroll
                for (int i = 0; i < 4; ++i) {
                    const float eB = __expf(B4[i]), emB = __expf(-B4[i]), qs = qv[i] * scale;
                    a0[i] = qs * eB; a1[i] = kv[i] * emB; a2[i] = qs * emB; a3[i] = kv[i] * eB;
                }
                const int off = lane * 272 + 2 * dl;
                *(u32x2*)(QF + off) = (u32x2){pk2(a0[0], a0[1]), pk2(a0[2], a0[3])}; *(u32x2*)(KF + off) = (u32x2){pk2(a1[0], a1[1]), pk2(a1[2], a1[3])};
                *(u32x2*)(QB + off) = (u32x2){pk2(a2[0], a2[1]), pk2(a2[2], a2[3])}; *(u32x2*)(KBW + off) = (u32x2){pk2(a3[0], a3[1]), pk2(a3[2], a3[3])};
            }
        }
        __syncthreads();
        {
            const int var = w >> 2, sb = w & 1, cb = (w >> 1) & 1;
            const char* Ab = (var ? KBW : KF) + (sb * 32 + lq) * 272 + h * 16; const char* Bb = (var ? QB : QF) + (cb * 32 + lq) * 272 + h * 16;
            f32x16 acc;
#pragma unroll
            for (int r = 0; r < 16; ++r) acc[r] = 0.f;
#pragma unroll
            for (int ks = 0; ks < 8; ++ks) acc = __builtin_amdgcn_mfma_f32_32x32x16_bf16(*(const bf16x8*)(Ab + ks * 32), *(const bf16x8*)(Bb + ks * 32), acc, 0, 0, 0);
            const int c = cb * 32 + lq;
#pragma unroll
            for (int r = 0; r < 16; ++r) {
                const int sidx = sb * 32 + (r & 3) + 8 * (r >> 2) + 4 * h;
                const bool keep = var ? (sidx > c) : (sidx <= c);
                if (keep) *(bf16_t*)(SC + c * 144 + sidx * 2) = f2bf(acc[r]);
            }
        }
        __syncthreads();
        u32x2 ggr[2][4];
#pragma unroll
        for (int cb = 0; cb < 2; ++cb)
#pragma unroll
            for (int i = 0; i < 4; ++i) ggr[cb][i] = *(const u32x2*)(p.gg + (tok0 + cb * 32 + lq) * 1024 + hh * 256 + 32 * w + 8 * i + 4 * h);
        f32x16 o[2];
#pragma unroll
        for (int cb = 0; cb < 2; ++cb) {
#pragma unroll
            for (int r = 0; r < 16; ++r) o[cb][r] = 0.f;
#pragma unroll
            for (int ks = 0; ks < 4; ++ks) o[cb] = __builtin_amdgcn_mfma_f32_32x32x16_bf16(aV[ks], *(const bf16x8*)(SC + (cb * 32 + lq) * 144 + ks * 32 + h * 16), o[cb], 0, 0, 0);
#pragma unroll
            for (int ks = 0; ks < 8; ++ks) o[cb] = __builtin_amdgcn_mfma_f32_32x32x16_bf16(aS[ks], *(const bf16x8*)(QF + (cb * 32 + lq) * 272 + ks * 32 + h * 16), o[cb], 0, 0, 0);
            float ss = 0.f;
#pragma unroll
            for (int r = 0; r < 16; ++r) ss += o[cb][r] * o[cb][r];
            ss += __shfl_xor(ss, 32);
            if (h == 0) atomicAdd(&ssum[cb * 32 + lq], ss);
        }
        __syncthreads();
#pragma unroll
        for (int cb = 0; cb < 2; ++cb) {
            const int c = cb * 32 + lq;
            const float rstd = rsqrtf(ssum[c] * (1.f / 256.f) + EPS);
            bf16_t* gp = p.gg + (tok0 + c) * 1024 + hh * 256;
#pragma unroll
            for (int i = 0; i < 4; ++i) {
                const int e0 = 32 * w + 8 * i + 4 * h;
                const u32x2 gr = ggr[cb][i];
                const f32x4 ng = *(const f32x4*)(p.gla_norm_g + e0);
                u32x2 ov;
                ov.x = pk2(o[cb][4 * i] * rstd * ng.x * __uint_as_float(gr.x << 16), o[cb][4 * i + 1] * rstd * ng.y * __uint_as_float(gr.x & 0xFFFF0000u));
                ov.y = pk2(o[cb][4 * i + 2] * rstd * ng.z * __uint_as_float(gr.y << 16), o[cb][4 * i + 3] * rstd * ng.w * __uint_as_float(gr.y & 0xFFFF0000u));
                *(u32x2*)(gp + e0) = ov;
            }
        }
    }
}

__device__ __forceinline__ void lds_barrier() { asm volatile("s_waitcnt lgkmcnt(0)" ::: "memory"); __builtin_amdgcn_s_barrier(); asm volatile("" ::: "memory"); }
__device__ __forceinline__ const bf16_t* kdt_ptr(const P& p, int bh, int n) { return (n < 24 ? p.kdtA : p.kdtB) + (size_t)(bh * 24 + (n < 24 ? n : n - 24)) * 8192; }
__device__ __forceinline__ void gla_prepass(const P& p, char* smem) {
    char* KD = smem;
    const int t = otid(), lane = t & 63, w = __builtin_amdgcn_readfirstlane(t >> 6);
    float* wl = (float*)(smem + 20480); gla_stage_w(p, wl, t);
    for (int item = blockIdx.x; item < 32 * 48; item += gridDim.x) {
        const int bh = item / 48, n = item % 48, b = bh >> 2, hh = bh & 3;
        const size_t tok0 = (size_t)b * 4096 + n * 64;
        __syncthreads();
        {
            float ac[16]; gla_load_ac(p, tok0, lane, ac);
            const bf16_t* kp = p.gk + (tok0 + lane) * 512 + hh * 128 + 16 * w;
            const u32x4 kA = *(const u32x4*)kp, kB = *(const u32x4*)(kp + 8);
#pragma unroll 1
            for (int grp = 0; grp < 4; ++grp) {
                const int dl = 16 * w + 4 * grp;
                u32x2 kr; kr.x = grp == 0 ? kA.x : grp == 1 ? kA.z : grp == 2 ? kB.x : kB.z; kr.y = grp == 0 ? kA.y : grp == 1 ? kA.w : grp == 2 ? kB.y : kB.w;
                float B4[4]; gla_gate4(wl, hh * 128 + dl, lane, ac, B4);
                const float kv[4] = {__uint_as_float(kr.x << 16), __uint_as_float(kr.x & 0xFFFF0000u), __uint_as_float(kr.y << 16), __uint_as_float(kr.y & 0xFFFF0000u)};
#pragma unroll
                for (int i = 0; i < 4; ++i) {
                    const float Bl = __builtin_bit_cast(float, __builtin_amdgcn_readlane(__builtin_bit_cast(int, B4[i]), 63));
                    *(bf16_t*)(KD + (dl + i) * 144 + lane * 2) = f2bf(kv[i] * __expf(Bl - B4[i]));
                    if (lane == 63) p.decg[(size_t)(bh * 48 + n) * 128 + dl + i] = __expf(B4[i]);
                }
            }
        }
        __syncthreads();
        {
            const int row = t >> 2, sg = t & 3;
            bf16_t* dst = (bf16_t*)kdt_ptr(p, bh, n) + row * 64 + sg * 16;
            const char* src = KD + row * 144 + sg * 32;
            *(u32x4*)dst = *(const u32x4*)src; *(u32x4*)(dst + 8) = *(const u32x4*)(src + 16);
        }
    }
}

__device__ __forceinline__ void gla_seq(const P& p, char* smem, int bh, int part) {
    constexpr int NPART = 4, CPP = 64 / NPART;
    constexpr int AB = 64 * 272;
    char* QF = smem; char* KF = smem + AB; char* QB = smem + 2 * AB; char* KBW = smem + 3 * AB; char* SC = smem + 4 * AB;
    char* KD0 = smem + 78848; char* KD1 = smem + 133120;
    float* ssum = (float*)(smem + 97280);
    float* dec0 = (float*)(smem + 97536); float* dec1 = (float*)(smem + 151552);
    float* wl = (float*)(smem + 98304);
    const int t = otid(), lane = t & 63, w = __builtin_amdgcn_readfirstlane(t >> 6), lq = lane & 31, h = lane >> 5;
    const float scale = 0.08838834764831845f;
    gla_stage_w(p, wl, t);
    const int b = bh >> 2, hh = bh & 3;
    f32x16 st[4];
#pragma unroll
    for (int db = 0; db < 4; ++db)
#pragma unroll
        for (int r = 0; r < 16; ++r) st[db][r] = 0.f;
    f32x4 acn[4]; u32x4 kAn, kBn;
#define GLA_LOAD_OPS(TOK) do { const size_t tk_ = (TOK); \
        _Pragma("unroll") for (int i = 0; i < 4; ++i) acn[i] = *(const f32x4*)(p.acode + (tk_ + lane) * 16 + 4 * i); \
        { const bf16_t* kp_ = p.gk + (tk_ + lane) * 512 + hh * 128 + 16 * w; \
          kAn = *(const u32x4*)kp_; kBn = *(const u32x4*)(kp_ + 8); } } while (0)
    const int nend = (part + 1) * CPP;
    for (int n = 0; n < nend; ++n) {
        const bool full = n >= part * CPP;
        const size_t tok0 = (size_t)b * 4096 + n * 64;
        if (!full) {
            const bf16_t* kd = kdt_ptr(p, bh, n); const float* dg = p.decg + (size_t)(bh * 48 + n) * 128;
            bf16x8 vR[4];
#pragma unroll
            for (int ks = 0; ks < 4; ++ks) vR[ks] = *(const bf16x8*)(p.gvT + (tok0 >> 6) * 65536 + (size_t)(hh * 256 + 32 * w + lq) * 64 + ks * 16 + h * 8);
#pragma unroll
            for (int db = 0; db < 4; ++db) {
                bf16x8 ak[4];
#pragma unroll
                for (int ks = 0; ks < 4; ++ks) ak[ks] = *(const bf16x8*)(kd + (db * 32 + lq) * 64 + ks * 16 + h * 8);
#pragma unroll
                for (int i = 0; i < 4; ++i) { const f32x4 dv = *(const f32x4*)(dg + db * 32 + 8 * i + 4 * h); st[db][4 * i] *= dv.x; st[db][4 * i + 1] *= dv.y; st[db][4 * i + 2] *= dv.z; st[db][4 * i + 3] *= dv.w; }
#pragma unroll
                for (int ks = 0; ks < 4; ++ks) st[db] = __builtin_amdgcn_mfma_f32_32x32x16_bf16(ak[ks], vR[ks], st[db], 0, 0, 0);
            }
            continue;
        }
        char* KD = KD0; float* dec = dec0;
        __syncthreads();
        if (t < 64) ssum[t] = 0.f;
        bf16x8 vT[4]; u32x2 ggr[2][4]; float ac[16];
        GLA_LOAD_OPS(tok0);
        const u32x4 kA = kAn, kB = kBn;
        u32x4 qA = {0u, 0u, 0u, 0u}, qB = {0u, 0u, 0u, 0u};
        if (full) { const bf16_t* qp_ = p.gq + (tok0 + lane) * 512 + hh * 128 + 16 * w; qA = __builtin_nontemporal_load((const u32x4*)qp_); qB = __builtin_nontemporal_load((const u32x4*)(qp_ + 8)); }
#pragma unroll
        for (int i = 0; i < 4; ++i) { ac[4 * i] = acn[i].x; ac[4 * i + 1] = acn[i].y; ac[4 * i + 2] = acn[i].z; ac[4 * i + 3] = acn[i].w; }
#pragma unroll
        for (int ks = 0; ks < 4; ++ks) vT[ks] = *(const bf16x8*)(p.gvT + (tok0 >> 6) * 65536 + (size_t)(hh * 256 + 32 * w + lq) * 64 + ks * 16 + h * 8);
        if (full) {
#pragma unroll
            for (int cb = 0; cb < 2; ++cb)
#pragma unroll
                for (int i = 0; i < 4; ++i) ggr[cb][i] = __builtin_nontemporal_load((const u32x2*)(p.gg + (tok0 + cb * 32 + lq) * 1024 + hh * 256 + 32 * w + 8 * i + 4 * h));
        }
        {
#pragma unroll 1
            for (int grp = 0; grp < 4; ++grp) {
                const int dl = 16 * w + 4 * grp;
                u32x2 qr, kr;
                qr.x = grp == 0 ? qA.x : grp == 1 ? qA.z : grp == 2 ? qB.x : qB.z; qr.y = grp == 0 ? qA.y : grp == 1 ? qA.w : grp == 2 ? qB.y : qB.w;
                kr.x = grp == 0 ? kA.x : grp == 1 ? kA.z : grp == 2 ? kB.x : kB.z; kr.y = grp == 0 ? kA.y : grp == 1 ? kA.w : grp == 2 ? kB.y : kB.w;
                float B4[4]; gla_gate4(wl, hh * 128 + dl, lane, ac, B4);
                const float qv[4] = {__uint_as_float(qr.x << 16), __uint_as_float(qr.x & 0xFFFF0000u), __uint_as_float(qr.y << 16), __uint_as_float(qr.y & 0xFFFF0000u)};
                const float kv[4] = {__uint_as_float(kr.x << 16), __uint_as_float(kr.x & 0xFFFF0000u), __uint_as_float(kr.y << 16), __uint_as_float(kr.y & 0xFFFF0000u)};
                float a0[4], a1[4], a2[4], a3[4];
#pragma unroll
                for (int i = 0; i < 4; ++i) {
                    const float eB = __expf(B4[i]), emB = __expf(-B4[i]), qs = qv[i] * scale;
                    a0[i] = qs * eB; a1[i] = kv[i] * emB; a2[i] = qs * emB; a3[i] = kv[i] * eB;
                    const float Bl = __builtin_bit_cast(float, __builtin_amdgcn_readlane(__builtin_bit_cast(int, B4[i]), 63));
                    *(bf16_t*)(KD + (dl + i) * 144 + lane * 2) = f2bf(kv[i] * emB * __expf(Bl));
                    if (lane == 63) dec[dl + i] = eB;
                }
                if (full) {
                    const int off = lane * 272 + 2 * dl;
                    *(u32x2*)(QF + off) = (u32x2){pk2(a0[0], a0[1]), pk2(a0[2], a0[3])}; *(u32x2*)(KF + off) = (u32x2){pk2(a1[0], a1[1]), pk2(a1[2], a1[3])};
                    *(u32x2*)(QB + off) = (u32x2){pk2(a2[0], a2[1]), pk2(a2[2], a2[3])}; *(u32x2*)(KBW + off) = (u32x2){pk2(a3[0], a3[1]), pk2(a3[2], a3[3])};
                }
            }
        }
        __syncthreads();
        f32x16 o[2];
        if (full) {
        {
            const int var = w >> 2, sb = w & 1, cb = (w >> 1) & 1;
            const char* Ab = (var ? KBW : KF) + (sb * 32 + lq) * 272 + h * 16; const char* Bb = (var ? QB : QF) + (cb * 32 + lq) * 272 + h * 16;
            f32x16 acc;
#pragma unroll
            for (int r = 0; r < 16; ++r) acc[r] = 0.f;
#pragma unroll
            for (int ks = 0; ks < 8; ++ks) acc = __builtin_amdgcn_mfma_f32_32x32x16_bf16(*(const bf16x8*)(Ab + ks * 32), *(const bf16x8*)(Bb + ks * 32), acc, 0, 0, 0);
            const int c = cb * 32 + lq;
#pragma unroll
            for (int r = 0; r < 16; ++r) {
                const int sidx = sb * 32 + (r & 3) + 8 * (r >> 2) + 4 * h;
                const bool keep = var ? (sidx > c) : (sidx <= c);
                if (keep) *(bf16_t*)(SC + c * 144 + sidx * 2) = f2bf(acc[r]);
            }
        }
        __syncthreads();
#pragma unroll
        for (int cb = 0; cb < 2; ++cb)
#pragma unroll
            for (int r = 0; r < 16; ++r) o[cb][r] = 0.f;
#pragma unroll
        for (int ks = 0; ks < 4; ++ks)
#pragma unroll
            for (int cb = 0; cb < 2; ++cb) o[cb] = __builtin_amdgcn_mfma_f32_32x32x16_bf16(vT[ks], *(const bf16x8*)(SC + (cb * 32 + lq) * 144 + ks * 32 + h * 16), o[cb], 0, 0, 0);
#pragma unroll
        for (int ks = 0; ks < 8; ++ks) {
            const int db = ks >> 1, s8 = (ks & 1) * 8;
            u32x4 pk; pk.x = pk2(st[db][s8 + 0], st[db][s8 + 1]); pk.y = pk2(st[db][s8 + 2], st[db][s8 + 3]); pk.z = pk2(st[db][s8 + 4], st[db][s8 + 5]); pk.w = pk2(st[db][s8 + 6], st[db][s8 + 7]);
            const bf16x8 aS = __builtin_bit_cast(bf16x8, pk);
#pragma unroll
            for (int cb = 0; cb < 2; ++cb) {
                const char* qrow = QF + (cb * 32 + lq) * 272 + ks * 32 + h * 8;
                const u32x2 lo = *(const u32x2*)qrow, hi = *(const u32x2*)(qrow + 16);
                const u32x4 bq = {lo.x, lo.y, hi.x, hi.y};
                o[cb] = __builtin_amdgcn_mfma_f32_32x32x16_bf16(aS, __builtin_bit_cast(bf16x8, bq), o[cb], 0, 0, 0);
            }
        }
#pragma unroll
        for (int cb = 0; cb < 2; ++cb) {
            float ss = 0.f;
#pragma unroll
            for (int r = 0; r < 16; ++r) ss += o[cb][r] * o[cb][r];
            ss += __shfl_xor(ss, 32);
            if (h == 0) atomicAdd(&ssum[cb * 32 + lq], ss);
        }
        }
#pragma unroll
        for (int db = 0; db < 4; ++db) {
#pragma unroll
            for (int i = 0; i < 4; ++i) {
                const f32x4 dv = *(const f32x4*)(dec + db * 32 + 8 * i + 4 * h);
                st[db][4 * i] *= dv.x; st[db][4 * i + 1] *= dv.y; st[db][4 * i + 2] *= dv.z; st[db][4 * i + 3] *= dv.w;
            }
#pragma unroll
            for (int ks = 0; ks < 4; ++ks) st[db] = __builtin_amdgcn_mfma_f32_32x32x16_bf16(*(const bf16x8*)(KD + (db * 32 + lq) * 144 + ks * 32 + h * 16), vT[ks], st[db], 0, 0, 0);
        }
        if (full) {
        __syncthreads();
#pragma unroll
        for (int cb = 0; cb < 2; ++cb) {
            const int c = cb * 32 + lq;
            const float rstd = rsqrtf(ssum[c] * (1.f / 256.f) + EPS);
            bf16_t* gp = p.gg + (tok0 + c) * 1024 + hh * 256;
#pragma unroll
            for (int i = 0; i < 4; ++i) {
                const int e0 = 32 * w + 8 * i + 4 * h;
                const u32x2 gr = ggr[cb][i];
                const f32x4 ng = *(const f32x4*)(p.gla_norm_g + e0);
                u32x2 ov;
                ov.x = pk2(o[cb][4 * i] * rstd * ng.x * __uint_as_float(gr.x << 16), o[cb][4 * i + 1] * rstd * ng.y * __uint_as_float(gr.x & 0xFFFF0000u));
                ov.y = pk2(o[cb][4 * i + 2] * rstd * ng.z * __uint_as_float(gr.y << 16), o[cb][4 * i + 3] * rstd * ng.w * __uint_as_float(gr.y & 0xFFFF0000u));
                *(u32x2*)(gp + e0) = ov;
            }
        }
        }
    }
    __syncthreads();
}

typedef const P __attribute__((address_space(4))) * KernargP;
__device__ __forceinline__ P load_params() {
#if defined(__HIP_DEVICE_COMPILE__)
    KernargP k = (KernargP)__builtin_amdgcn_kernarg_segment_ptr(); asm volatile("" : "+s"(k)); return *k;
#else
    return P{};
#endif
}
__global__ __launch_bounds__(512, 2) void mega(P p_unused, int pb, int pe, int rmask) {
    extern __shared__ __attribute__((aligned(16))) char smem[];
    cg::grid_group grid = cg::this_grid();
    float* fl = (float*)smem;
    for (int ph = pb; ph < pe; ++ph) {
      {
        const P p = load_params();
        switch (ph) {
            case 0: if (blockIdx.x == 0 && threadIdx.x == 0) *p.ctr = 0u; phase_mod(p, fl); __syncthreads(); phase_convert(p, fl); break;
            case 1: phase_norm(p, p.x, p.norm1_g, 0, 1024, p.h); break;
            case 2:
                run_gemm(smem, p.h, p.wt_in1, T, 4352, 1024, FastEpi<EpiP1>{EpiP1{p}});
                run_gemm(smem, p.h, p.wt_in2, T, 2048, 1024, FastEpi<EpiP2>{EpiP2{p}});
                run_gemm(smem, p.wt_gv, p.h, 2048, T, 1024, FastEpiVT{p.gvT, p.dvT});
                break;
            case 3: gla_prepass(p, smem); break;
            case 4:
                if (blockIdx.x < 128) gla_seq(p, smem, (int)blockIdx.x & 31, (int)blockIdx.x >> 5);
                attn_phase(p, smem);
                break;
            case 5:
                run_gemm(smem, p.gg, p.wt_glao, T, 1024, 1024, FastEpi<EpiM1>{EpiM1{p}});
                run_gemm(smem, p.h, p.wt_diffo, T, 1024, 1024, FastEpi<EpiMG>{EpiMG{p}});
                break;
            case 6: run_gemm(smem, p.merged, p.wt_out, T, 1024, 1024, FastEpi<EpiX1>{EpiX1{p}}); break;
            case 7: phase_norm_b(p, p.x1b, p.norm2_g, 3072, 4096, p.h); break;
            case 8: run_gemm(smem, p.h, p.wt_up, T, 5632, 1024, FastEpiUpConv{p, smem + 131072}); break;
            case 9: fixup_phase(p); break;
            case 10: run_gemm(smem, p.act, p.wt_down, T, 1024, 2816, FastEpi<EpiOut>{EpiOut{p}}); break;
        }
      }
        if (ph + 1 < pe) grid.sync();
#ifdef XSYNC
        for (int q = 0; q < XSYNC; ++q) grid.sync();
#endif
    }
}

constexpr size_t MEGA_LDS = 160 * 1024;
#ifndef RMASK
#define RMASK 0
#endif
static int g_grid = 0;
static void launch_mega(const P& p, int pb, int pe, hipStream_t stream) {
    P pp = p; int a = pb, b = pe, rm = RMASK;
    void* args[] = {&pp, &a, &b, &rm};
    hipError_t e = hipLaunchCooperativeKernel((const void*)mega, dim3(g_grid), dim3(512), args, MEGA_LDS, stream);
    if (e != hipSuccess) fprintf(stderr, "cooperative launch failed: %s (grid %d)\n", hipGetErrorString(e), g_grid);
}

extern "C" void kernel_launch(void* const* d_in, const int* in_sizes, int n_in, void* d_out, int out_size, void* d_ws, size_t ws_size, hipStream_t stream) {
    P p{};
    const float** f = (const float**)&p;
    for (int i = 0; i < 24; ++i) f[i] = (const float*)d_in[i];
    p.out = (float*)d_out;
    char* ws = (char*)d_ws; size_t off = 0;
    const size_t MiB = 1u << 20;
    auto take = [&](size_t bytes) { char* r = ws + off; off += (bytes + 255) & ~(size_t)255; return r; };
    p.wt_in1 = (bf16_t*)take((size_t)4352 * 1024 * 2); p.wt_in2 = (bf16_t*)take((size_t)2048 * 1024 * 2);
    p.wt_gv = (bf16_t*)take(2 * MiB); p.wt_dv = (bf16_t*)take(2 * MiB);
    p.wt_glao = (bf16_t*)take(2 * MiB); p.wt_diffo = (bf16_t*)take(2 * MiB); p.wt_out = (bf16_t*)take(2 * MiB);
    p.wt_up = (bf16_t*)take((size_t)5632 * 1024 * 2); p.wt_down = (bf16_t*)take((size_t)1024 * 2816 * 2);
    p.mod = (float*)take(8 * 6144 * 4);
    p.ctr = (unsigned*)take(256);
    off = 40 * MiB;
    p.h = (bf16_t*)take(64 * MiB);
    char* big = ws + off;
    p.gq = (bf16_t*)(big); p.gk = (bf16_t*)(big + 32 * MiB); p.gg = (bf16_t*)(big + 64 * MiB); p.gvT = (bf16_t*)(big + 128 * MiB);
    p.acode = (float*)(big + 192 * MiB); p.decay = (float*)(big + 192 * MiB); p.delta = (bf16_t*)(big + 194 * MiB);
    p.dq = (bf16_t*)(big + 194 * MiB); p.dk = (bf16_t*)(big + 258 * MiB); p.dvT = (bf16_t*)(big + 322 * MiB); p.merged = (bf16_t*)(big);
    p.uh = (bf16_t*)(big); p.act = (bf16_t*)(big + 128 * MiB); p.ubnd = (bf16_t*)(big + 386 * MiB); p.x1b = (bf16_t*)(big + 64 * MiB);
    p.kdtA = (bf16_t*)ws; p.kdtB = (bf16_t*)(big + 386 * MiB); p.decg = (float*)(big + 399 * MiB);
    p.sga = (bf16_t*)d_out; p.sgb = (bf16_t*)d_out + (size_t)T * 1024;
    if (ws_size < 496 * MiB) { fprintf(stderr, "workspace too small: %zu\n", ws_size); return; }

    if (!g_grid) {
        (void)hipFuncSetAttribute((const void*)mega, hipFuncAttributeMaxDynamicSharedMemorySize, (int)MEGA_LDS);
        int dev = 0, cus = 0, per_cu = 0;
        (void)hipGetDevice(&dev);
        (void)hipDeviceGetAttribute(&cus, hipDeviceAttributeMultiprocessorCount, dev);
        (void)hipOccupancyMaxActiveBlocksPerMultiprocessor(&per_cu, mega, 512, MEGA_LDS);
        if (per_cu < 1) per_cu = 1;
        g_grid = cus * per_cu;
    }
    launch_mega(p, 0, 11, stream);
}
```
